# Optimizing an MI355X kernel written in HIP

```python
import math
import jax, jax.numpy as jnp
from jax import lax
import numpy as np

D_MODEL = 1024
BATCH = 8
SEQ = 4096
DEPTH = 1

MIX_WIDTH = D_MODEL
HEAD_DIM = 64
GMLP_GROUPS = 8
GMLP_WIDTH = GMLP_GROUPS * HEAD_DIM
CHUNK = 128
N_Q_HEADS = 8
N_KV_HEADS = 2
GQA_GROUP = N_Q_HEADS // N_KV_HEADS
ATTN_WIDTH = N_Q_HEADS * HEAD_DIM
KV_WIDTH = N_KV_HEADS * HEAD_DIM
WINDOW = 128
Q_BLOCK = 128
ROPE_THETA = 500000.0
ROT_DIM = HEAD_DIM // 4
D_FF = 4 * D_MODEL
IN_PROJ_WIDTH = 2 * GMLP_WIDTH + ATTN_WIDTH + 2 * KV_WIDTH
N_MOD = 6
EPS = 1e-5

kernel_name = "hybrid_gmlp_swa_sink_block"


def rms_norm(x, g):
    xf = x.astype(jnp.float32)
    y = xf * lax.rsqrt(jnp.mean(xf * xf, axis=-1, keepdims=True) + EPS)
    return (y * g.astype(jnp.float32)).astype(x.dtype)


def modulate(h, shift, scale):
    return h * (1 + scale[:, None, :]) + shift[:, None, :]


def partial_rope(t, positions):
    half = ROT_DIM // 2
    inv_freq = ROPE_THETA ** (-jnp.arange(0, ROT_DIM, 2, dtype=jnp.float32) / ROT_DIM)
    ang = positions.astype(jnp.float32)[..., None] * inv_freq
    cos = jnp.cos(ang)[:, :, None, :].astype(t.dtype)
    sin = jnp.sin(ang)[:, :, None, :].astype(t.dtype)
    t1 = t[..., :half]
    t2 = t[..., half:ROT_DIM]
    return jnp.concatenate([t1 * cos - t2 * sin, t2 * cos + t1 * sin, t[..., ROT_DIM:]], axis=-1)


def chunked_sgu(z, w_s, b_s):
    B, S, _ = z.shape
    n_chunks = S // CHUNK
    u, v = jnp.split(z, 2, axis=-1)
    v = v.reshape(B, n_chunks, CHUNK, GMLP_GROUPS, HEAD_DIM)
    causal = jnp.tril(jnp.ones((CHUNK, CHUNK), dtype=w_s.dtype))
    w = w_s * causal[None]
    sv = jnp.einsum('hts,bcshd->bcthd', w, v) + jnp.transpose(b_s)[None, None, :, :, None]
    return u * sv.reshape(B, S, GMLP_WIDTH)


def sliding_window_sink_attention(q, k, v, sinks, positions):
    B, S, _, _ = q.shape
    nb = S // Q_BLOCK
    q = partial_rope(q, positions)
    k = partial_rope(k, positions)
    qb = q.reshape(B, nb, Q_BLOCK, N_KV_HEADS, GQA_GROUP, HEAD_DIM)
    pad = jnp.zeros((B, Q_BLOCK, N_KV_HEADS, HEAD_DIM), k.dtype)
    kp = jnp.concatenate([pad, k], axis=1)
    vp = jnp.concatenate([pad, v], axis=1)
    kb = jnp.concatenate([kp[:, :S].reshape(B, nb, Q_BLOCK, N_KV_HEADS, HEAD_DIM),
                          k.reshape(B, nb, Q_BLOCK, N_KV_HEADS, HEAD_DIM)], axis=2)
    vb = jnp.concatenate([vp[:, :S].reshape(B, nb, Q_BLOCK, N_KV_HEADS, HEAD_DIM),
                          v.reshape(B, nb, Q_BLOCK, N_KV_HEADS, HEAD_DIM)], axis=2)
    scores = jnp.einsum('bnqhgd,bnkhd->bnhgqk', qb, kb).astype(jnp.float32) / math.sqrt(HEAD_DIM)
    qi = jnp.arange(Q_BLOCK)[:, None]
    kj = jnp.arange(2 * Q_BLOCK)[None, :]
    band = (kj > qi) & (kj <= qi + WINDOW)
    valid_first = jnp.arange(nb)[:, None, None] > 0
    mask = band[None] & (valid_first | (kj >= Q_BLOCK)[None])
    mask = mask[None, :, None, None]
    scores = jnp.where(mask, scores, -jnp.inf)
    sink = sinks.astype(jnp.float32).reshape(N_KV_HEADS, GQA_GROUP)[None, None, :, :, None, None]
    m = jnp.maximum(jnp.max(scores, axis=-1, keepdims=True), sink)
    p = jnp.exp(scores - m)
    denom = jnp.sum(p, axis=-1, keepdims=True) + jnp.exp(sink - m)
    probs = (p / denom).astype(v.dtype)
    out = jnp.einsum('bnhgqk,bnkhd->bnqhgd', probs, vb)
    return out.reshape(B, S, ATTN_WIDTH)


def setup_inputs(seed: int = 0) -> dict:
    key = jax.random.key(seed)
    ks = jax.random.split(key, 16)
    f32 = jnp.float32
    x = jax.random.normal(ks[0], (BATCH, SEQ, D_MODEL), f32)
    c = jax.random.normal(ks[1], (BATCH, D_MODEL), f32)
    offsets = jax.random.randint(ks[2], (BATCH, 1), 0, 2048, dtype=jnp.int32)
    positions = offsets + jnp.arange(SEQ, dtype=jnp.int32)[None, :]
    w_ada = jax.random.normal(ks[3], (DEPTH, D_MODEL, N_MOD * D_MODEL), f32) * (0.5 * D_MODEL ** -0.5)
    b_ada = jax.random.normal(ks[4], (DEPTH, N_MOD * D_MODEL), f32) * 0.02
    g_mix = 1.0 + 0.02 * jax.random.normal(ks[5], (DEPTH, D_MODEL), f32)
    w_in = jax.random.normal(ks[6], (DEPTH, D_MODEL, IN_PROJ_WIDTH), f32) * D_MODEL ** -0.5
    w_spatial = jax.random.normal(ks[7], (DEPTH, GMLP_GROUPS, CHUNK, CHUNK), f32) * CHUNK ** -0.5
    b_spatial = 1.0 + 0.01 * jax.random.normal(ks[8], (DEPTH, GMLP_GROUPS, CHUNK), f32)
    sinks = jax.random.normal(ks[9], (DEPTH, N_Q_HEADS), f32) * 0.5
    w_out = jax.random.normal(ks[10], (DEPTH, MIX_WIDTH, D_MODEL), f32) * MIX_WIDTH ** -0.5
    g_ffn = 1.0 + 0.02 * jax.random.normal(ks[11], (DEPTH, D_MODEL), f32)
    w_ff1 = jax.random.normal(ks[12], (DEPTH, D_MODEL, D_FF), f32) * D_MODEL ** -0.5
    w_ff2 = jax.random.normal(ks[13], (DEPTH, D_FF, D_MODEL), f32) * D_FF ** -0.5
    g_final = 1.0 + 0.02 * jax.random.normal(ks[14], (D_MODEL,), f32)
    return {"x": x, "c": c, "positions": positions, "w_ada": w_ada, "b_ada": b_ada,
            "g_mix": g_mix, "w_in": w_in, "w_spatial": w_spatial, "b_spatial": b_spatial,
            "sinks": sinks, "w_out": w_out, "g_ffn": g_ffn, "w_ff1": w_ff1, "w_ff2": w_ff2,
            "g_final": g_final}


def reference(x, c, positions, w_ada, b_ada, g_mix, w_in, w_spatial, b_spatial, sinks,
              w_out, g_ffn, w_ff1, w_ff2, g_final):
    B, S, _ = x.shape
    c_act = jax.nn.silu(c)
    for l in range(DEPTH):
        mod = c_act @ w_ada[l] + b_ada[l]
        shift1, scale1, gate1, shift2, scale2, gate2 = jnp.split(mod, N_MOD, axis=-1)

        h = modulate(rms_norm(x, g_mix[l]), shift1, scale1)
        proj = h @ w_in[l]
        z_a = proj[..., :2 * GMLP_WIDTH]
        o = 2 * GMLP_WIDTH
        q = proj[..., o:o + ATTN_WIDTH].reshape(B, S, N_Q_HEADS, HEAD_DIM)
        o += ATTN_WIDTH
        k = proj[..., o:o + KV_WIDTH].reshape(B, S, N_KV_HEADS, HEAD_DIM)
        o += KV_WIDTH
        v = proj[..., o:o + KV_WIDTH].reshape(B, S, N_KV_HEADS, HEAD_DIM)

        out_a = chunked_sgu(jax.nn.gelu(z_a), w_spatial[l], b_spatial[l])
        out_b = sliding_window_sink_attention(q, k, v, sinks[l], positions)
        mix = jnp.concatenate([out_a, out_b], axis=-1) @ w_out[l]
        x = x + gate1[:, None, :] * mix

        h2 = modulate(rms_norm(x, g_ffn[l]), shift2, scale2)
        ff = jnp.square(jax.nn.relu(h2 @ w_ff1[l])) @ w_ff2[l]
        x = x + gate2[:, None, :] * ff
    return rms_norm(x, g_final)
```

```cpp
#include <hip/hip_runtime.h>
#include <hip/hip_cooperative_groups.h>
#include <cstdio>
#include <cstdint>
namespace cg = cooperative_groups;
namespace pg8 {
#define PG8_LAS __attribute__((address_space(3)))
typedef unsigned short bf16_t;
typedef short bf16x8 __attribute__((ext_vector_type(8)));
typedef float f32x4 __attribute__((ext_vector_type(4)));
typedef unsigned u32x4 __attribute__((ext_vector_type(4)));
constexpr int BM = 256, BK = 64, HALF = 128, HTB = HALF * BK * 2  , STAGE_BYTES = 8 * HTB, NXCD = 8, WGM = 8;

__host__ __device__ __forceinline__ int lds_byte(int r, int c) { const int st = (r >> 4) * 2 + (c >> 5), rr = r & 15, cc = c & 31, ob = rr * 64 + cc * 2; return st * 1024 + (ob ^ (((ob >> 9) & 1) << 5)); }
__host__ __device__ __forceinline__ void stage_rc(int b, int& R, int& C) { const int st = b / 1024, sb = b % 1024, swz = sb ^ (((sb >> 9) & 1) << 5); R = (st >> 1) * 16 + swz / 64; C = (st & 1) * 32 + (swz % 64) / 2; }
__host__ __device__ __forceinline__ int perm32(int rho) { const int n = rho >> 4, i = rho & 15; return 8 * (i >> 2) + 4 * n + (i & 3); }

struct Unit { int pm, pn; };
struct Gemm { const bf16_t* A; const bf16_t* Bt; int M, N, K; };

struct StaticOrder {
    int nM, nN, nwg, G, c;
    __host__ __device__ void init(int M, int N, int G_, int c_) { nM = M / BM; nN = N / BM; nwg = nM * nN; G = G_; c = c_; }
    __host__ __device__ bool next(int i, Unit& u) const {
        const long L = (long)i * G + c; if (L >= nwg) return false;
        int wgid = (int)L; { const int q = nwg / NXCD, r = nwg % NXCD, xcd = wgid % NXCD, off = wgid / NXCD; wgid = (xcd < r ? xcd * (q + 1) : r * (q + 1) + (xcd - r) * q) + off; }
        const int nig = WGM * nN, gid = wgid / nig, fm = gid * WGM, gsz = (nM - fm) < WGM ? (nM - fm) : WGM;
        u.pm = fm + ((wgid % nig) % gsz); u.pn = (wgid % nig) / gsz; return true;
    }
    __device__ __forceinline__ void a_ready(const Unit&) const {}
    __device__ __forceinline__ void done(const Unit&) const {}
};

__device__ __forceinline__ unsigned cvt_pk_bf16(float lo, float hi) { unsigned r; asm volatile("v_cvt_pk_bf16_f32 %0, %1, %2" : "=v"(r) : "v"(lo), "v"(hi)); return r; }
typedef float f32x2 __attribute__((ext_vector_type(2)));
__device__ __forceinline__ float gelu_tanh(float v) {
    const float u = v * (1.0f + 0.044715f * v * v);
    const float e = __builtin_amdgcn_exp2f(u * (-2.0f * 0.7978845608028654f * 1.4426950408889634f));
    return v * __builtin_amdgcn_rcpf(1.0f + e);
}
struct EpiIn {
    static constexpr bool PERM = true, AFTER_DRAIN = false;
    bf16_t* O; const float* rope; float qscale;
    __device__ __forceinline__ void operator()(const f32x4 (&acc)[2][2][4][2], const Unit& u, int wr, int wc, int fr, int fq) const {
        constexpr int ldc = 1792;
        const int row0 = u.pm * BM + wr * 64 + fr, col0 = u.pn * BM + wc * 32 + 8 * fq;
        const int kind = u.pn < 4 ? 0 : (u.pn < 6 ? 1 : 2);
        const bool ropelane = ((wc & 1) == 0) && (fq < 2);
        const float sgn = (fq == 0) ? -1.f : 1.f;
#pragma unroll
        for (int ai = 0; ai < 2; ++ai)
#pragma unroll
            for (int m = 0; m < 4; ++m) {
                const int row = row0 + ai * HALF + m * 16;
                bf16_t* rowp = O + (size_t)row * ldc + col0;
                f32x4 cs[4];
                if (kind != 0) { const f32x4* rp = (const f32x4*)(rope + (size_t)row * 16);
#pragma unroll
                    for (int i = 0; i < 4; ++i) cs[i] = rp[i]; }
#pragma unroll
                for (int bj = 0; bj < 2; ++bj) {
                    f32x4 v0 = acc[ai][bj][m][0], v1 = acc[ai][bj][m][1];
                    if (kind == 0) {
#pragma unroll
                        for (int e = 0; e < 4; ++e) { v0[e] = gelu_tanh(v0[e]); v1[e] = gelu_tanh(v1[e]); }
                    } else {
                        if (kind == 1 || bj == 0) {
                            f32x4 p0, p1;
#pragma unroll
                            for (int e = 0; e < 4; ++e) { p0[e] = __shfl_xor(v0[e], 16); p1[e] = __shfl_xor(v1[e], 16); }
                            if (ropelane) {
#pragma unroll
                                for (int e = 0; e < 4; ++e) {
                                    const float c0 = cs[e >> 1][(e & 1) * 2], s0 = cs[e >> 1][(e & 1) * 2 + 1];
                                    const float c1 = cs[2 + (e >> 1)][(e & 1) * 2], s1 = cs[2 + (e >> 1)][(e & 1) * 2 + 1];
                                    v0[e] = v0[e] * c0 + sgn * p0[e] * s0;
                                    v1[e] = v1[e] * c1 + sgn * p1[e] * s1;
                                }
                            }
                        }
                        if (kind == 1) { v0 = v0 * qscale; v1 = v1 * qscale; }
                    }
                    u32x4 w; w.x = cvt_pk_bf16(v0[0], v0[1]); w.y = cvt_pk_bf16(v0[2], v0[3]); w.z = cvt_pk_bf16(v1[0], v1[1]); w.w = cvt_pk_bf16(v1[2], v1[3]);
                    *(u32x4*)(rowp + bj * HALF) = w;
                }
            }
    }
};
struct EpiRelu2 {
    static constexpr bool PERM = true, AFTER_DRAIN = false;
    bf16_t* O; int ldc;
    __device__ __forceinline__ void operator()(const f32x4 (&acc)[2][2][4][2], const Unit& u, int wr, int wc, int fr, int fq) const {
        const int row0 = u.pm * BM + wr * 64 + fr, col0 = u.pn * BM + wc * 32 + 8 * fq;
#pragma unroll
        for (int ai = 0; ai < 2; ++ai)
#pragma unroll
            for (int m = 0; m < 4; ++m) { bf16_t* rowp = O + (size_t)(row0 + ai * HALF + m * 16) * ldc + col0;
#pragma unroll
                for (int bj = 0; bj < 2; ++bj) { f32x4 v0 = acc[ai][bj][m][0], v1 = acc[ai][bj][m][1];
#pragma unroll
                    for (int e = 0; e < 4; ++e) { const float a = fmaxf(v0[e], 0.f), b = fmaxf(v1[e], 0.f); v0[e] = a * a; v1[e] = b * b; }
                    u32x4 w; w.x = cvt_pk_bf16(v0[0], v0[1]); w.y = cvt_pk_bf16(v0[2], v0[3]); w.z = cvt_pk_bf16(v1[0], v1[1]); w.w = cvt_pk_bf16(v1[2], v1[3]);
                    *(u32x4*)(rowp + bj * HALF) = w; } }
    }
};
struct EpiResid {
    static constexpr bool PERM = false, AFTER_DRAIN = false;
    const float* base; float* out; const float* gate; int gate_ld;
    __device__ __forceinline__ void operator()(const f32x4 (&acc)[2][2][4][2], const Unit& u, int wr, int wc, int fr, int fq) const {
        constexpr int ldc = 1024;
        const int b = u.pm >> 4;
        const int col0 = u.pn * BM + wc * 32 + 4 * fq;
        f32x4 gv[2][2];
#pragma unroll
        for (int bj = 0; bj < 2; ++bj)
#pragma unroll
            for (int n = 0; n < 2; ++n) gv[bj][n] = *(const f32x4*)(gate + (size_t)b * gate_ld + col0 + bj * HALF + n * 16);
#pragma unroll
        for (int ai = 0; ai < 2; ++ai)
#pragma unroll
            for (int m = 0; m < 4; ++m) { const size_t off = (size_t)(u.pm * BM + ai * HALF + wr * 64 + m * 16 + fr) * ldc + col0;
#pragma unroll
                for (int bj = 0; bj < 2; ++bj)
#pragma unroll
                    for (int n = 0; n < 2; ++n) { const f32x4 bs = *(const f32x4*)(base + off + bj * HALF + n * 16);
                        *(f32x4*)(out + off + bj * HALF + n * 16) = bs + gv[bj][n] * acc[ai][bj][m][n]; }
                if (m & 1) asm volatile("" ::: "memory"); }
    }
};

template <class Epi, class Sched, bool ALIGN_EPI = false, bool SP2 = false>
__device__ __forceinline__ void gemm_phase(PG8_LAS unsigned char* lds, const Gemm g, const Sched& S, const Epi& E) {
    const int tid = threadIdx.x, wid = __builtin_amdgcn_readfirstlane(tid >> 6), lane = tid & 63, wr = wid >> 2, wc = wid & 3, fr = lane & 15, fq = lane >> 4;
    const int K = g.K, nt = K / BK;
    unsigned voffA[2], voffB[2];
#pragma unroll
    for (int i = 0; i < 2; ++i) { int R, C; stage_rc(tid * 16 + i * 8192, R, C); const int Rb = Epi::PERM ? ((R & ~31) + perm32(R & 31)) : R;
        voffA[i] = (unsigned)(R * K + C) * 2u; voffB[i] = (unsigned)(Rb * K + C) * 2u; }
    const size_t kstep = (size_t)(BK * 2);
    const size_t hstep = (size_t)HALF * K * 2;
    const size_t tstep = 2 * hstep;
    const unsigned ldsw = (unsigned)wid * 1024u;
    const int aoff = lds_byte(wr * 64 + fr, fq * 8), boff = lds_byte(wc * 32 + fr, fq * 8);
#define PG8_SA(b, h) (((b) * 2 + (h)) * HTB)
#define PG8_SB(b, h) ((4 + (b) * 2 + (h)) * HTB)
#define PG8_STAGE(bufoff, gbase, voff) do { _Pragma("unroll") for (int _i = 0; _i < 2; ++_i) \
        __builtin_amdgcn_global_load_lds((const unsigned*)((const char*)(gbase) + (voff)[_i]), (PG8_LAS unsigned*)(lds + (bufoff) + ldsw + _i * 8192), 16, 0, 0); } while (0)
#define PG8_LDA(dst, b, h) do { _Pragma("unroll") for (int m = 0; m < 4; ++m) _Pragma("unroll") for (int k = 0; k < 2; ++k) dst[m][k] = *(const PG8_LAS bf16x8*)(lds + PG8_SA(b, h) + aoff + m * 2048 + k * 1024); } while (0)
#define PG8_LDB(dst, b, h) do { _Pragma("unroll") for (int n = 0; n < 2; ++n) _Pragma("unroll") for (int k = 0; k < 2; ++k) dst[n][k] = *(const PG8_LAS bf16x8*)(lds + PG8_SB(b, h) + boff + n * 2048 + k * 1024); } while (0)
#define PG8_MMA(ai, bj, At, Bt) do { __builtin_amdgcn_s_setprio(1); _Pragma("unroll") for (int m = 0; m < 4; ++m) _Pragma("unroll") for (int n = 0; n < 2; ++n) _Pragma("unroll") for (int k = 0; k < 2; ++k) \
        acc[ai][bj][m][n] = __builtin_amdgcn_mfma_f32_16x16x32_bf16(Bt[n][k], At[m][k], acc[ai][bj][m][n], 0, 0, 0); __builtin_amdgcn_s_setprio(0); } while (0)
#define PG8_WAIT_V(n) asm volatile("s_waitcnt vmcnt(" #n ")" ::: "memory")
#define PG8_WAIT_L(n) asm volatile("s_waitcnt lgkmcnt(" #n ")" ::: "memory")
#define PG8_BAR __builtin_amdgcn_s_barrier()
#define PG8_SCHED __builtin_amdgcn_sched_barrier(0)
    Unit cur, nxt; int ui = 0;
    if (!S.next(0, cur)) return;
    f32x4 acc[2][2][4][2];
#pragma unroll
    for (int a = 0; a < 2; ++a)
#pragma unroll
        for (int b = 0; b < 2; ++b)
#pragma unroll
            for (int m = 0; m < 4; ++m)
#pragma unroll
                for (int n = 0; n < 2; ++n) acc[a][b][m][n] = (f32x4){0.f, 0.f, 0.f, 0.f};
    bf16x8 At[4][2], B0[2][2], B1[2][2];
    const char* cA = (const char*)g.A + (size_t)cur.pm * tstep; const char* cB = (const char*)g.Bt + (size_t)cur.pn * tstep;
    S.a_ready(cur);
    if constexpr (SP2) {
        PG8_STAGE(PG8_SB(0, 0), cB, voffB); PG8_STAGE(PG8_SB(0, 1), cB + hstep, voffB); PG8_STAGE(PG8_SA(0, 0), cA, voffA); PG8_STAGE(PG8_SA(0, 1), cA + hstep, voffA);
        if (wr == 1) PG8_BAR;
        PG8_WAIT_V(2); PG8_BAR;
        PG8_STAGE(PG8_SB(1, 0), cB + kstep, voffB); PG8_STAGE(PG8_SA(1, 0), cA + kstep, voffA); PG8_STAGE(PG8_SB(1, 1), cB + hstep + kstep, voffB);
        PG8_WAIT_V(6); PG8_BAR;
    } else {
        PG8_STAGE(PG8_SB(0, 0), cB, voffB); PG8_STAGE(PG8_SA(0, 0), cA, voffA); PG8_STAGE(PG8_SB(0, 1), cB + hstep, voffB); PG8_STAGE(PG8_SA(0, 1), cA + hstep, voffA);
        if (wr == 1) PG8_BAR;
        PG8_WAIT_V(4); PG8_BAR;
        PG8_STAGE(PG8_SB(1, 0), cB + kstep, voffB); PG8_STAGE(PG8_SA(1, 0), cA + kstep, voffA); PG8_STAGE(PG8_SB(1, 1), cB + hstep + kstep, voffB);
        PG8_WAIT_V(6); PG8_BAR;
    }
    for (;;) {
        const bool has_next = S.next(ui + 1, nxt);
        const char* nA = has_next ? (const char*)g.A + (size_t)nxt.pm * tstep : cA; const char* nB = has_next ? (const char*)g.Bt + (size_t)nxt.pn * tstep : cB;
        for (int t = 0; t < nt; t += 2) {
            const bool last = (t == nt - 2);
            const char* a1 = cA + (size_t)(t + 1) * kstep;
            const char* a2 = last ? nA : cA + (size_t)(t + 2) * kstep; const char* b2 = last ? nB : cB + (size_t)(t + 2) * kstep;
            const char* a3 = a2 + kstep; const char* b3 = b2 + kstep;
            if (last && has_next) S.a_ready(nxt);
            if constexpr (SP2) {
            PG8_LDB(B0, 0, 0); PG8_LDB(B1, 0, 1); PG8_SCHED; PG8_LDA(At, 0, 0); PG8_STAGE(PG8_SA(1, 1), a1 + hstep, voffA);
            PG8_WAIT_V(8); PG8_WAIT_L(0); PG8_BAR; PG8_MMA(0, 0, At, B0); PG8_MMA(0, 1, At, B1); PG8_BAR; PG8_SCHED;
            PG8_LDA(At, 0, 1); PG8_STAGE(PG8_SB(0, 0), b2, voffB); PG8_STAGE(PG8_SB(0, 1), b2 + hstep, voffB); PG8_STAGE(PG8_SA(0, 0), a2, voffA);
            PG8_WAIT_V(8); PG8_WAIT_L(0); PG8_BAR; PG8_MMA(1, 0, At, B0); PG8_MMA(1, 1, At, B1); PG8_BAR; PG8_SCHED;
            PG8_LDB(B0, 1, 0); PG8_LDB(B1, 1, 1); PG8_SCHED; PG8_LDA(At, 1, 0); PG8_STAGE(PG8_SA(0, 1), a2 + hstep, voffA);
            PG8_WAIT_V(8); PG8_WAIT_L(0); PG8_BAR; PG8_MMA(0, 0, At, B0); PG8_MMA(0, 1, At, B1); PG8_BAR; PG8_SCHED;
            PG8_LDA(At, 1, 1); PG8_STAGE(PG8_SB(1, 0), b3, voffB); PG8_STAGE(PG8_SB(1, 1), b3 + hstep, voffB); PG8_STAGE(PG8_SA(1, 0), a3, voffA);
            PG8_WAIT_V(8); PG8_WAIT_L(0); PG8_BAR; PG8_MMA(1, 0, At, B0); PG8_MMA(1, 1, At, B1); PG8_BAR; PG8_SCHED;
            } else {
            PG8_LDB(B0, 0, 0); PG8_SCHED; PG8_LDA(At, 0, 0); PG8_STAGE(PG8_SA(1, 1), a1 + hstep, voffA);
            PG8_WAIT_L(8); PG8_BAR; PG8_WAIT_L(0); PG8_MMA(0, 0, At, B0); PG8_BAR; PG8_SCHED;
            PG8_LDB(B1, 0, 1); PG8_STAGE(PG8_SB(0, 0), b2, voffB);
            PG8_BAR; PG8_WAIT_L(0); PG8_MMA(0, 1, At, B1); PG8_BAR;
            PG8_LDA(At, 0, 1); PG8_STAGE(PG8_SA(0, 0), a2, voffA);
            PG8_BAR; PG8_WAIT_L(0); PG8_MMA(1, 0, At, B0); PG8_BAR; PG8_SCHED;
            PG8_STAGE(PG8_SB(0, 1), b2 + hstep, voffB);
            PG8_WAIT_V(6); PG8_BAR; PG8_MMA(1, 1, At, B1); PG8_BAR;
            PG8_LDB(B0, 1, 0); PG8_SCHED; PG8_LDA(At, 1, 0); PG8_STAGE(PG8_SA(0, 1), a2 + hstep, voffA);
            PG8_WAIT_L(8); PG8_BAR; PG8_WAIT_L(0); PG8_MMA(0, 0, At, B0); PG8_BAR; PG8_SCHED;
            PG8_LDB(B1, 1, 1); PG8_STAGE(PG8_SB(1, 0), b3, voffB);
            PG8_BAR; PG8_WAIT_L(0); PG8_MMA(0, 1, At, B1); PG8_BAR;
            PG8_LDA(At, 1, 1); PG8_STAGE(PG8_SA(1, 0), a3, voffA);
            PG8_BAR; PG8_WAIT_L(0); PG8_MMA(1, 0, At, B0); PG8_BAR; PG8_SCHED;
            PG8_STAGE(PG8_SB(1, 1), b3 + hstep, voffB);
            PG8_WAIT_V(6); PG8_BAR; PG8_MMA(1, 1, At, B1); PG8_BAR;
            }
        }
        if constexpr (ALIGN_EPI) { if (wr == 0) PG8_BAR; }
        if constexpr (!Epi::AFTER_DRAIN) { E(acc, cur, wr, wc, fr, fq); S.done(cur); }
        if (!has_next) break;
#pragma unroll
        for (int a = 0; a < 2; ++a)
#pragma unroll
            for (int b = 0; b < 2; ++b)
#pragma unroll
                for (int m = 0; m < 4; ++m)
#pragma unroll
                    for (int n = 0; n < 2; ++n) acc[a][b][m][n] = (f32x4){0.f, 0.f, 0.f, 0.f};
        cur = nxt; cA = nA; cB = nB; ++ui;
        if constexpr (ALIGN_EPI) { if (wr == 1) PG8_BAR; }
    }
    PG8_WAIT_V(0);
    if constexpr (!ALIGN_EPI) { if (wr == 0) PG8_BAR; }
    PG8_BAR;
    if constexpr (Epi::AFTER_DRAIN) { E.fused(acc, cur, wr, wc, fr, fq, lds, wid, lane); S.done(cur); }
#undef PG8_SA
#undef PG8_SB
#undef PG8_STAGE
#undef PG8_LDA
#undef PG8_LDB
#undef PG8_MMA
#undef PG8_WAIT_V
#undef PG8_WAIT_L
#undef PG8_BAR
#undef PG8_SCHED
}
}

constexpr int NB = 8, SEQ = 4096, D = 1024, M = NB * SEQ, NPROJ = 1792, FF = 4096, NMOD = 6144, KSPLIT = 32;
constexpr float RMS_EPS = 1e-5f;
constexpr float LOG2E = 1.4426950408889634f;
constexpr float QSCALE = 0.125f * LOG2E;
constexpr int NWAVES = 8, NTHREADS = NWAVES * 64;
constexpr int N_PHASES = 9;
#ifndef MK_MULTI
#define MK_MULTI 0
#endif

constexpr size_t MiB = 1u << 20;
constexpr size_t WS_WIN = 2 * MiB, WS_WOUT = 6 * MiB, WS_W1 = 8 * MiB, WS_W2 = 16 * MiB;
constexpr size_t WS_MOD = 24 * MiB;
constexpr size_t WS_ROPE = 25 * MiB;
constexpr size_t WS_WSP = 27 * MiB;
constexpr size_t WS_MODP = 28 * MiB;
constexpr size_t WS_XN = 40 * MiB;
constexpr size_t WS_PROJ = 104 * MiB;
constexpr size_t WS_MIX = 216 * MiB;
constexpr size_t WS_HID = 104 * MiB;
constexpr size_t WS_END = 360 * MiB;

constexpr int RING_BYTES = 131072;
constexpr int LDS_BYTES = 147456;

#define LAS __attribute__((address_space(3)))
typedef unsigned short bf16;
typedef unsigned v4u __attribute__((ext_vector_type(4)));
typedef unsigned v2u __attribute__((ext_vector_type(2)));
typedef float f32x4 __attribute__((ext_vector_type(4)));
typedef float f32x16 __attribute__((ext_vector_type(16)));
typedef short bf16x8 __attribute__((ext_vector_type(8)));
typedef short s16x4 __attribute__((ext_vector_type(4)));
#define LDS_WAIT() asm volatile("s_waitcnt lgkmcnt(0)" ::: "memory")

__device__ __forceinline__ unsigned f2bf(float f) { unsigned u = __builtin_bit_cast(unsigned, f); return (u + 0x7fffu + ((u >> 16) & 1u)) >> 16; }
__device__ __forceinline__ unsigned pk2(float lo, float hi) { return f2bf(lo) | (f2bf(hi) << 16); }
__device__ __forceinline__ float bflo(unsigned u) { return __builtin_bit_cast(float, u << 16); }
__device__ __forceinline__ float bfhi(unsigned u) { return __builtin_bit_cast(float, u & 0xffff0000u); }
__device__ __forceinline__ float wave_sum(float v) {
#pragma unroll
    for (int o = 1; o < 64; o <<= 1) v += __shfl_xor(v, o);
    return v;
}

struct Args {
    const float *x, *c; const int* pos; const float *w_ada, *b_ada, *g_mix, *w_in, *w_sp, *b_sp, *sinks, *w_out, *g_ffn, *w_ff1, *w_ff2, *g_final;
    float* out; unsigned char* ws; int ph_lo, ph_hi;
};

__device__ __forceinline__ void p0_transpose_item(const float* W, int K, int N, bf16* WT, LAS float* scr, int item, int lane) {
    const int nblk = N / 32, kb = item / nblk, nb = item % nblk, k0 = 64 * kb, n0 = 32 * nb;
#pragma unroll 8
    for (int i = 0; i < 32; ++i) { const int kk = 2 * i + (lane >> 5); scr[kk * 33 + (lane & 31)] = W[(size_t)(k0 + kk) * N + n0 + (lane & 31)]; }
    LDS_WAIT(); asm volatile("" ::: "memory");
    const int c = lane & 7;
#pragma unroll
    for (int j = 0; j < 4; ++j) { const int n = (lane >> 3) + 8 * j; const LAS float* s = scr + (8 * c) * 33 + n;
        v4u o; o.x = pk2(s[0 * 33], s[1 * 33]); o.y = pk2(s[2 * 33], s[3 * 33]); o.z = pk2(s[4 * 33], s[5 * 33]); o.w = pk2(s[6 * 33], s[7 * 33]);
        *(v4u*)(WT + (size_t)(n0 + n) * K + k0 + 8 * c) = o; }
    LDS_WAIT(); asm volatile("" ::: "memory");
}
__device__ __forceinline__ void p0_mod_item(const float* c, const float* w_ada, float* modp, LAS float* scr, int item, int lane) {
    const int cb = item % 24, ks = item / 24;
#pragma unroll
    for (int i = 0; i < 4; ++i) { const int idx = lane * 4 + i, b = idx >> 5, kk = idx & 31; const float v = c[b * D + ks * 32 + kk]; scr[idx] = v / (1.0f + __expf(-v)); }
    LDS_WAIT(); asm volatile("" ::: "memory");
    f32x4 acc[8];
#pragma unroll
    for (int b = 0; b < 8; ++b) acc[b] = (f32x4){0.f, 0.f, 0.f, 0.f};
    const f32x4* wp = (const f32x4*)(w_ada + (size_t)(ks * 32) * NMOD + cb * 256) + lane;
#pragma unroll 8
    for (int kk = 0; kk < 32; ++kk) { const f32x4 w = wp[(size_t)kk * (NMOD / 4)];
#pragma unroll
        for (int b = 0; b < 8; ++b) acc[b] += scr[b * 32 + kk] * w; }
#pragma unroll
    for (int b = 0; b < 8; ++b) *(f32x4*)(modp + (size_t)(ks * 8 + b) * NMOD + cb * 256 + lane * 4) = acc[b];
    LDS_WAIT(); asm volatile("" ::: "memory");
}
__device__ __forceinline__ void p0_rope_item(const int* pos, float* rope, int item, int lane) {
    const int idx = item * 64 + lane, m = idx >> 3, i = idx & 7;
    const float invf = i == 0 ? 1.0f : i == 1 ? 0.19392274474868576f : i == 2 ? 0.03760603093086393f : i == 3 ? 0.007292664737217109f
                     : i == 4 ? 0.001414213562373095f : i == 5 ? 0.0002742481756762073f : i == 6 ? 5.318295896944988e-05f : 1.031338537721246e-05f;
    const float ang = (float)pos[m] * invf;
    const double a = (double)ang, k = __builtin_rint(a * 0.15915494309189535), r = a - k * 6.283185307179586;
    const float rf = (float)r;
    float2 cs; cs.x = cosf(rf); cs.y = sinf(rf);
    *(float2*)(rope + (size_t)idx * 2) = cs;
}
__device__ __forceinline__ void p0_wsp_item(const float* w_sp, bf16* wsp, int item, int lane) {
    const int e0 = (item * 64 + lane) * 4, t = (e0 >> 7) & 127, s0 = e0 & 127;
    f32x4 v = *(const f32x4*)(w_sp + e0);
#pragma unroll
    for (int j = 0; j < 4; ++j) if (s0 + j > t) v[j] = 0.f;
    v2u o; o.x = pk2(v[0], v[1]); o.y = pk2(v[2], v[3]);
    *(v2u*)(wsp + e0) = o;
}

template <bool FIRST>
__device__ __forceinline__ void norm_mod_pass(LAS unsigned char* lds, const float* xin, const float* g, const float* b_ada, const float* modp, float* mod, int shift_off, int scale_off, bf16* out) {
    const int tid = threadIdx.x, lane = tid & 63, wave = tid >> 6;
    LAS float* GS = (LAS float*)lds; LAS float* SH = GS + D;
    for (int grp = blockIdx.x; grp < 256; grp += gridDim.x) {
        const int b = grp >> 5, j = grp & 31;
        if (FIRST) {
            for (int col = tid; col < 2 * D; col += NTHREADS) {
                float s = b_ada[col];
                for (int ks = 0; ks < KSPLIT; ++ks) s += modp[(size_t)(ks * 8 + b) * NMOD + col];
                if (col < D) SH[col] = s; else GS[col - D] = g[col - D] * (1.0f + s);
            }
            if (tid < 128) { const int col = 2 * D + j * 128 + tid;
                float s = b_ada[col];
                for (int ks = 0; ks < KSPLIT; ++ks) s += modp[(size_t)(ks * 8 + b) * NMOD + col];
                mod[(size_t)b * NMOD + col] = s; }
        } else {
            for (int col = tid; col < D; col += NTHREADS) { SH[col] = mod[(size_t)b * NMOD + shift_off + col]; GS[col] = g[col] * (1.0f + mod[(size_t)b * NMOD + scale_off + col]); }
        }
        __syncthreads();
        for (int i = 0; i < 16; ++i) {
            const size_t row = (size_t)b * SEQ + j * 128 + wave * 16 + i;
            const f32x4* xr = (const f32x4*)(xin + row * D) + lane;
            f32x4 v[4]; float s = 0.f;
#pragma unroll
            for (int q = 0; q < 4; ++q) { v[q] = xr[64 * q]; s += (v[q].x * v[q].x + v[q].y * v[q].y) + (v[q].z * v[q].z + v[q].w * v[q].w); }
            const float rstd = 1.0f / sqrtf(wave_sum(s) * (1.0f / D) + RMS_EPS);
            unsigned long long* o8 = (unsigned long long*)(out + row * D) + lane;
#pragma unroll
            for (int q = 0; q < 4; ++q) { const f32x4 gs = *(const LAS f32x4*)(GS + 256 * q + 4 * lane), sh = *(const LAS f32x4*)(SH + 256 * q + 4 * lane);
                const f32x4 y = v[q] * rstd * gs + sh;
                o8[64 * q] = (unsigned long long)pk2(y.x, y.y) | ((unsigned long long)pk2(y.z, y.w) << 32); }
        }
        __syncthreads();
    }
}
__device__ __forceinline__ void final_norm_pass(float* io, const float* g) {
    const int lane = threadIdx.x & 63, gw = blockIdx.x * NWAVES + (threadIdx.x >> 6), NGW = gridDim.x * NWAVES;
    f32x4 gv[4];
#pragma unroll
    for (int q = 0; q < 4; ++q) gv[q] = *((const f32x4*)g + lane + 64 * q);
    for (int m = gw; m < M; m += NGW) {
        f32x4* xr = (f32x4*)(io + (size_t)m * D) + lane;
        f32x4 v[4]; float s = 0.f;
#pragma unroll
        for (int q = 0; q < 4; ++q) { v[q] = xr[64 * q]; s += (v[q].x * v[q].x + v[q].y * v[q].y) + (v[q].z * v[q].z + v[q].w * v[q].w); }
        const float rstd = 1.0f / sqrtf(wave_sum(s) * (1.0f / D) + RMS_EPS);
#pragma unroll
        for (int q = 0; q < 4; ++q) xr[64 * q] = v[q] * rstd * gv[q];
    }
}

__device__ __forceinline__ int crow(int r, int hi) { return (r & 3) + 8 * (r >> 2) + 4 * hi; }
__device__ __forceinline__ s16x4 vtr(LAS const unsigned char* p) { return __builtin_bit_cast(s16x4, __builtin_amdgcn_ds_read_tr16_b64_v4i16((LAS s16x4*)p)); }
__device__ __forceinline__ bf16x8 vfrag(LAS const unsigned char* vb, int key0) {
    const s16x4 lo = vtr(vb + key0 * 64), hi = vtr(vb + key0 * 64 + 512);
    return (bf16x8){lo[0], lo[1], lo[2], lo[3], hi[0], hi[1], hi[2], hi[3]};
}
__device__ __forceinline__ unsigned cvtpk(float lo, float hi) { return pg8::cvt_pk_bf16(lo, hi); }

__device__ __forceinline__ void sgu_unit(LAS unsigned char* lds, const bf16* proj, const bf16* wsp, const float* b_sp, bf16* mix, int b, int c) {
    const int tid = threadIdx.x, lane = tid & 63, h = tid >> 6, hi = lane >> 5;
    const size_t m0 = (size_t)b * SEQ + c * 128;
    LAS unsigned char* vl = lds + h * 16384;
#pragma unroll
    for (int half = 0; half < 2; ++half) {
        v4u tmp[8];
#pragma unroll
        for (int i = 0; i < 8; ++i) { const int idx = lane + 64 * (half * 8 + i), row = idx >> 3, ch = idx & 7;
            tmp[i] = *(const v4u*)(proj + (m0 + row) * NPROJ + 512 + h * 64 + ch * 8); }
#pragma unroll
        for (int i = 0; i < 8; ++i) { const int idx = lane + 64 * (half * 8 + i), row = idx >> 3, ch = idx & 7;
            *(LAS v4u*)(vl + (ch >> 2) * 8192 + row * 64 + (ch & 3) * 16) = tmp[i]; }
    }
    LDS_WAIT(); asm volatile("" ::: "memory");
    const int lofs = (4 * hi + ((lane & 15) >> 2)) * 64 + 32 * ((lane >> 4) & 1) + 8 * (lane & 3);
    LAS const unsigned char* vb0 = vl + lofs; LAS const unsigned char* vb1 = vl + 8192 + lofs;
#pragma unroll
    for (int tt = 0; tt < 4; ++tt) {
        f32x16 acc0 = {}, acc1 = {};
        const int t = 32 * tt + (lane & 31);
        const bf16* wrow = wsp + ((size_t)h * 128 + t) * 128;
#pragma unroll
        for (int j = 0; j < 2 * (tt + 1); ++j) {
            const v2u w0 = *(const v2u*)(wrow + 16 * j + 4 * hi), w1 = *(const v2u*)(wrow + 16 * j + 8 + 4 * hi);
            const bf16x8 bw = __builtin_bit_cast(bf16x8, ((v4u){w0.x, w0.y, w1.x, w1.y}));
            const bf16x8 a0 = vfrag(vb0, 16 * j), a1 = vfrag(vb1, 16 * j);
            acc0 = __builtin_amdgcn_mfma_f32_32x32x16_bf16(a0, bw, acc0, 0, 0, 0);
            acc1 = __builtin_amdgcn_mfma_f32_32x32x16_bf16(a1, bw, acc1, 0, 0, 0);
        }
        const float bias = b_sp[h * 128 + t];
        const size_t mrow = m0 + t;
#pragma unroll
        for (int dblk = 0; dblk < 2; ++dblk)
#pragma unroll
            for (int rg = 0; rg < 4; ++rg) {
                const int d = 32 * dblk + 8 * rg + 4 * hi;
                const v2u uu = *(const v2u*)(proj + mrow * NPROJ + h * 64 + d);
                const f32x16& a = dblk ? acc1 : acc0;
                const float o0 = (a[4 * rg + 0] + bias) * bflo(uu.x), o1 = (a[4 * rg + 1] + bias) * bfhi(uu.x);
                const float o2 = (a[4 * rg + 2] + bias) * bflo(uu.y), o3 = (a[4 * rg + 3] + bias) * bfhi(uu.y);
                v2u o; o.x = cvtpk(o0, o1); o.y = cvtpk(o2, o3);
                *(v2u*)(mix + mrow * D + h * 64 + d) = o;
            }
    }
}

constexpr int AT_KSTRIDE = 144, AT_VOFF = 256 * AT_KSTRIDE;
__device__ __forceinline__ void attn_unit(LAS unsigned char* lds, const bf16* proj, const float* sinks, bf16* mix, int b, int n, int hk) {
    const int tid = threadIdx.x, lane = tid & 63, wave = tid >> 6, hi = lane >> 5, qi = lane & 31;
    const long m0 = (long)b * SEQ + n * 128;
    LAS unsigned char* kl = lds; LAS unsigned char* vl = lds + AT_VOFF;
#pragma unroll
    for (int i = 0; i < 4; ++i) {
        const int idx = tid + NTHREADS * i, row = idx >> 3, ch = idx & 7;
        const bool valid = (n > 0) || (row >= 128);
        v4u kk = (v4u){0u, 0u, 0u, 0u}, vv = (v4u){0u, 0u, 0u, 0u};
        if (valid) { const bf16* src = proj + (size_t)(m0 - 128 + row) * NPROJ + hk * 64 + ch * 8; kk = *(const v4u*)(src + 1536); vv = *(const v4u*)(src + 1664); }
        *(LAS v4u*)(kl + row * AT_KSTRIDE + ch * 16) = kk;
        *(LAS v4u*)(vl + (ch >> 2) * 16384 + row * 64 + (ch & 3) * 16) = vv;
    }
    __syncthreads();
    const int hq = hk * 4 + (wave >> 1);
    const float sink2 = sinks[hq] * LOG2E;
    const int lofs = (4 * hi + ((lane & 15) >> 2)) * 64 + 32 * ((lane >> 4) & 1) + 8 * (lane & 3);
    LAS const unsigned char* vb0 = vl + lofs; LAS const unsigned char* vb1 = vl + 16384 + lofs;
    const float NEG = -__builtin_inff();
#pragma unroll 1
    for (int sub = 0; sub < 2; ++sub) {
        const int i0 = 64 * (wave & 1) + 32 * sub, jt0 = i0 >> 5;
        const size_t mrow = (size_t)(m0 + i0 + qi);
        bf16x8 qf[4];
#pragma unroll
        for (int ds = 0; ds < 4; ++ds) qf[ds] = *(const bf16x8*)(proj + mrow * NPROJ + 1024 + hq * 64 + 16 * ds + 8 * hi);
        f32x16 S[5];
#pragma unroll
        for (int tt = 0; tt < 5; ++tt) {
            LAS const unsigned char* kp = kl + (32 * (jt0 + tt) + qi) * AT_KSTRIDE + 16 * hi;
            f32x16 s = {};
#pragma unroll
            for (int ds = 0; ds < 4; ++ds) { const bf16x8 kf = *(LAS const bf16x8*)(kp + 32 * ds); s = __builtin_amdgcn_mfma_f32_32x32x16_bf16(kf, qf[ds], s, 0, 0, 0); }
            S[tt] = s;
        }
#pragma unroll
        for (int r = 0; r < 16; ++r) { const int kr = crow(r, hi); if (!(kr > qi)) S[0][r] = NEG; if (!(kr <= qi)) S[4][r] = NEG; }
        if (n == 0) {
#pragma unroll
            for (int tt = 0; tt < 5; ++tt) if (jt0 + tt < 4) {
#pragma unroll
                for (int r = 0; r < 16; ++r) S[tt][r] = NEG; }
        }
        float mx = sink2;
#pragma unroll
        for (int tt = 0; tt < 5; ++tt)
#pragma unroll
            for (int r = 0; r < 16; ++r) mx = fmaxf(mx, S[tt][r]);
        mx = fmaxf(mx, __shfl_xor(mx, 32));
        float sum = 0.f;
#pragma unroll
        for (int tt = 0; tt < 5; ++tt)
#pragma unroll
            for (int r = 0; r < 16; ++r) { const float p = __builtin_amdgcn_exp2f(S[tt][r] - mx); S[tt][r] = p; sum += p; }
        sum += __shfl_xor(sum, 32);
        sum += __builtin_amdgcn_exp2f(sink2 - mx);
        const float inv = 1.0f / sum;
        f32x16 O0 = {}, O1 = {};
#pragma unroll
        for (int tt = 0; tt < 5; ++tt)
#pragma unroll
            for (int ks = 0; ks < 2; ++ks) {
                const v4u pw = (v4u){cvtpk(S[tt][8 * ks + 0], S[tt][8 * ks + 1]), cvtpk(S[tt][8 * ks + 2], S[tt][8 * ks + 3]), cvtpk(S[tt][8 * ks + 4], S[tt][8 * ks + 5]), cvtpk(S[tt][8 * ks + 6], S[tt][8 * ks + 7])};
                const bf16x8 pb = __builtin_bit_cast(bf16x8, pw);
                const int key0 = 32 * (jt0 + tt) + 16 * ks;
                const bf16x8 a0 = vfrag(vb0, key0), a1 = vfrag(vb1, key0);
                O0 = __builtin_amdgcn_mfma_f32_32x32x16_bf16(a0, pb, O0, 0, 0, 0);
                O1 = __builtin_amdgcn_mfma_f32_32x32x16_bf16(a1, pb, O1, 0, 0, 0);
            }
#pragma unroll
        for (int dblk = 0; dblk < 2; ++dblk)
#pragma unroll
            for (int rg = 0; rg < 4; ++rg) {
                const int d = 32 * dblk + 8 * rg + 4 * hi;
                const f32x16& a = dblk ? O1 : O0;
                v2u o; o.x = cvtpk(a[4 * rg + 0] * inv, a[4 * rg + 1] * inv); o.y = cvtpk(a[4 * rg + 2] * inv, a[4 * rg + 3] * inv);
                *(v2u*)(mix + mrow * D + 512 + hq * 64 + d) = o;
            }
    }
    __syncthreads();
}

__global__ void __launch_bounds__(NTHREADS, 2) mk_fwd(Args args) {
    extern __shared__ __attribute__((aligned(16))) unsigned char lds_raw[];
    LAS unsigned char* lds = (LAS unsigned char*)lds_raw;
    const int tid = threadIdx.x, lane = tid & 63, wave = __builtin_amdgcn_readfirstlane(tid >> 6);
    const int G = gridDim.x;
    unsigned char* ws = args.ws;
    bf16* Win_t = (bf16*)(ws + WS_WIN); bf16* Wout_t = (bf16*)(ws + WS_WOUT); bf16* W1_t = (bf16*)(ws + WS_W1); bf16* W2_t = (bf16*)(ws + WS_W2);
    float* MOD = (float*)(ws + WS_MOD); float* ROPE = (float*)(ws + WS_ROPE); bf16* WSP = (bf16*)(ws + WS_WSP); float* MODP = (float*)(ws + WS_MODP);
    bf16* XN = (bf16*)(ws + WS_XN); bf16* PROJ = (bf16*)(ws + WS_PROJ); bf16* MIX = (bf16*)(ws + WS_MIX); bf16* HID = (bf16*)(ws + WS_HID);
    const int lo = args.ph_lo, hi = args.ph_hi;
#define IN(k) (lo <= (k) && (k) < hi)
#define SEAM(k) do { if (IN(k) && IN((k) + 1)) { cg::this_grid().sync(); } } while (0)

    if (IN(0)) {
        LAS float* scr = (LAS float*)(lds + wave * 16384);
        const int gw = blockIdx.x * NWAVES + wave, NGW = G * NWAVES;
        constexpr int I_MOD = 24 * KSPLIT, I_IN = (D / 64) * (NPROJ / 32), I_OUT = (D / 64) * (D / 32), I_1 = (D / 64) * (FF / 32), I_2 = (FF / 64) * (D / 32);
        constexpr int I_ROPE = M * 8 / 64, I_WSP = 8 * 128 * 128 / 256;
        constexpr int NITEMS = I_MOD + I_IN + I_OUT + I_1 + I_2 + I_ROPE + I_WSP;
        for (int it = gw; it < NITEMS; it += NGW) {
            int r = it;
            if (r < I_MOD) { p0_mod_item(args.c, args.w_ada, MODP, scr, r, lane); continue; } r -= I_MOD;
            if (r < I_IN) { p0_transpose_item(args.w_in, D, NPROJ, Win_t, scr, r, lane); continue; } r -= I_IN;
            if (r < I_OUT) { p0_transpose_item(args.w_out, D, D, Wout_t, scr, r, lane); continue; } r -= I_OUT;
            if (r < I_1) { p0_transpose_item(args.w_ff1, D, FF, W1_t, scr, r, lane); continue; } r -= I_1;
            if (r < I_2) { p0_transpose_item(args.w_ff2, FF, D, W2_t, scr, r, lane); continue; } r -= I_2;
            if (r < I_ROPE) { p0_rope_item(args.pos, ROPE, r, lane); continue; } r -= I_ROPE;
            p0_wsp_item(args.w_sp, WSP, r, lane);
        }
    }
    SEAM(0);
    if (IN(1)) norm_mod_pass<true>(lds, args.x, args.g_mix, args.b_ada, MODP, MOD, 0, 0, XN);
    SEAM(1);
    if (IN(2)) {
        pg8::Gemm g{XN, Win_t, M, NPROJ, D}; pg8::StaticOrder S; S.init(M, NPROJ, G, (int)blockIdx.x);
        pg8::EpiIn E{PROJ, ROPE, QSCALE};
        pg8::gemm_phase<pg8::EpiIn, pg8::StaticOrder, true, true>(lds, g, S, E);
    }
    SEAM(2);
    if (IN(3)) {
        for (int u = blockIdx.x; u < 768; u += G) {
            if (u < 256) { sgu_unit(lds, PROJ, WSP, args.b_sp, MIX, u >> 5, u & 31); __syncthreads(); }
            else { const int idx = u - 256; attn_unit(lds, PROJ, args.sinks, MIX, idx >> 6, (idx >> 1) & 31, idx & 1); }
        }
    }
    SEAM(3);
    if (IN(4)) {
        pg8::Gemm g{MIX, Wout_t, M, D, D}; pg8::StaticOrder S; S.init(M, D, G, (int)blockIdx.x);
        pg8::EpiResid E{args.x, args.out, MOD + 2 * D, NMOD};
        pg8::gemm_phase<pg8::EpiResid, pg8::StaticOrder, true, true>(lds, g, S, E);
    }
    SEAM(4);
    if (IN(5)) norm_mod_pass<false>(lds, args.out, args.g_ffn, args.b_ada, MODP, MOD, 3 * D, 4 * D, XN);
    SEAM(5);
    if (IN(6)) {
        pg8::Gemm g{XN, W1_t, M, FF, D}; pg8::StaticOrder S; S.init(M, FF, G, (int)blockIdx.x);
        pg8::EpiRelu2 E{HID, FF};
        pg8::gemm_phase<pg8::EpiRelu2, pg8::StaticOrder, true, true>(lds, g, S, E);
    }
    SEAM(6);
    if (IN(7)) {
        pg8::Gemm g{HID, W2_t, M, D, FF}; pg8::StaticOrder S; S.init(M, D, G, (int)blockIdx.x);
        pg8::EpiResid E{args.out, args.out, MOD + 5 * D, NMOD};
        pg8::gemm_phase<pg8::EpiResid, pg8::StaticOrder, true, true>(lds, g, S, E);
    }
    SEAM(7);
    if (IN(8)) final_norm_pass(args.out, args.g_final);
#undef IN
#undef SEAM
}

extern "C" void kernel_launch(void* const* d_in, const int* in_sizes, int n_in, void* d_out, int out_size, void* d_ws, size_t ws_size, hipStream_t stream) {
    static int grid = 0;
    if (grid == 0) {
        if (n_in != 15 || in_sizes[0] != M * D || out_size != M * D || ws_size < WS_END) { fprintf(stderr, "kernel_launch: unexpected shapes (n_in %d, in0 %d, out %d, ws %zu); nothing launched\n", n_in, n_in > 0 ? in_sizes[0] : -1, out_size, ws_size); grid = -1; return; }
        int dev = 0, cus = 0, per_cu = 0;
        if (hipGetDevice(&dev) != hipSuccess || hipDeviceGetAttribute(&cus, hipDeviceAttributeMultiprocessorCount, dev) != hipSuccess) { grid = -1; return; }
        if (hipFuncSetAttribute((const void*)mk_fwd, hipFuncAttributeMaxDynamicSharedMemorySize, LDS_BYTES) != hipSuccess) { fprintf(stderr, "kernel_launch: hipFuncSetAttribute failed\n"); grid = -1; return; }
        if (hipOccupancyMaxActiveBlocksPerMultiprocessor(&per_cu, (const void*)mk_fwd, NTHREADS, LDS_BYTES) != hipSuccess || per_cu < 1) { fprintf(stderr, "kernel_launch: occupancy query says %d\n", per_cu); per_cu = 1; }
        (void)hipGetLastError();
        grid = cus * per_cu;
        if (grid > 256) grid = 256;
    }
    if (grid < 0) return;
    Args a{};
    a.x = (const float*)d_in[0]; a.c = (const float*)d_in[1]; a.pos = (const int*)d_in[2]; a.w_ada = (const float*)d_in[3]; a.b_ada = (const float*)d_in[4];
    a.g_mix = (const float*)d_in[5]; a.w_in = (const float*)d_in[6]; a.w_sp = (const float*)d_in[7]; a.b_sp = (const float*)d_in[8]; a.sinks = (const float*)d_in[9];
    a.w_out = (const float*)d_in[10]; a.g_ffn = (const float*)d_in[11]; a.w_ff1 = (const float*)d_in[12]; a.w_ff2 = (const float*)d_in[13]; a.g_final = (const float*)d_in[14];
    a.out = (float*)d_out; a.ws = (unsigned char*)d_ws;
#if MK_MULTI
    for (int ph = 0; ph < N_PHASES; ++ph) { a.ph_lo = ph; a.ph_hi = ph + 1; hipLaunchKernelGGL(mk_fwd, dim3(grid), dim3(NTHREADS), LDS_BYTES, stream, a); }
#else
    a.ph_lo = 0; a.ph_hi = N_PHASES;
    void* kargs[] = {&a};
    hipError_t e = hipLaunchCooperativeKernel((const void*)mk_fwd, dim3(grid), dim3(NTHREADS), kargs, LDS_BYTES, stream);
    if (e != hipSuccess) fprintf(stderr, "kernel_launch: cooperative launch failed: %s (grid %d)\n", hipGetErrorString(e), grid);
#endif
}
```

```cpp
#include <hip/hip_runtime.h>
#include <hip/hip_cooperative_groups.h>
#include <cstdio>
#include <cstdint>
namespace cg = cooperative_groups;
namespace pg8 {
#define PG8_LAS __attribute__((address_space(3)))
typedef unsigned short bf16_t;
typedef short bf16x8 __attribute__((ext_vector_type(8)));
typedef float f32x4 __attribute__((ext_vector_type(4)));
typedef unsigned u32x4 __attribute__((ext_vector_type(4)));
constexpr int BM = 256, BK = 64, HALF = 128, HTB = HALF * BK * 2  , STAGE_BYTES = 8 * HTB, NXCD = 8, WGM = 8;

__host__ __device__ __forceinline__ int lds_byte(int r, int c) { const int st = (r >> 4) * 2 + (c >> 5), rr = r & 15, cc = c & 31, ob = rr * 64 + cc * 2; return st * 1024 + (ob ^ (((ob >> 9) & 1) << 5)); }
__host__ __device__ __forceinline__ void stage_rc(int b, int& R, int& C) { const int st = b / 1024, sb = b % 1024, swz = sb ^ (((sb >> 9) & 1) << 5); R = (st >> 1) * 16 + swz / 64; C = (st & 1) * 32 + (swz % 64) / 2; }
__host__ __device__ __forceinline__ int perm32(int rho) { const int n = rho >> 4, i = rho & 15; return 8 * (i >> 2) + 4 * n + (i & 3); }

struct Unit { int pm, pn; };
struct Gemm { const bf16_t* A; const bf16_t* Bt; int M, N, K; };

struct StaticOrder {
    int nM, nN, nwg, G, c;
    __host__ __device__ void init(int M, int N, int G_, int c_) { nM = M / BM; nN = N / BM; nwg = nM * nN; G = G_; c = c_; }
    __host__ __device__ bool next(int i, Unit& u) const {
        const long L = (long)i * G + c; if (L >= nwg) return false;
        int wgid = (int)L; { const int q = nwg / NXCD, r = nwg % NXCD, xcd = wgid % NXCD, off = wgid / NXCD; wgid = (xcd < r ? xcd * (q + 1) : r * (q + 1) + (xcd - r) * q) + off; }
        const int nig = WGM * nN, gid = wgid / nig, fm = gid * WGM, gsz = (nM - fm) < WGM ? (nM - fm) : WGM;
        u.pm = fm + ((wgid % nig) % gsz); u.pn = (wgid % nig) / gsz; return true;
    }
    __device__ __forceinline__ void a_ready(const Unit&) const {}
    __device__ __forceinline__ void done(const Unit&) const {}
};

__device__ __forceinline__ unsigned cvt_pk_bf16(float lo, float hi) { unsigned r; asm volatile("v_cvt_pk_bf16_f32 %0, %1, %2" : "=v"(r) : "v"(lo), "v"(hi)); return r; }
typedef float f32x2 __attribute__((ext_vector_type(2)));
__device__ __forceinline__ float gelu_tanh(float v) {
    const float u = v * (1.0f + 0.044715f * v * v);
    const float e = __builtin_amdgcn_exp2f(u * (-2.0f * 0.7978845608028654f * 1.4426950408889634f));
    return v * __builtin_amdgcn_rcpf(1.0f + e);
}
struct EpiIn {
    static constexpr bool PERM = true, AFTER_DRAIN = false;
    bf16_t* O; const float* rope; float qscale;
    __device__ __forceinline__ void operator()(const f32x4 (&acc)[2][2][4][2], const Unit& u, int wr, int wc, int fr, int fq) const {
        constexpr int ldc = 1792;
        const int row0 = u.pm * BM + wr * 64 + fr, col0 = u.pn * BM + wc * 32 + 8 * fq;
        const int kind = u.pn < 4 ? 0 : (u.pn < 6 ? 1 : 2);
        const bool ropelane = ((wc & 1) == 0) && (fq < 2);
        const float sgn = (fq == 0) ? -1.f : 1.f;
#pragma unroll
        for (int ai = 0; ai < 2; ++ai)
#pragma unroll
            for (int m = 0; m < 4; ++m) {
                const int row = row0 + ai * HALF + m * 16;
                bf16_t* rowp = O + (size_t)row * ldc + col0;
                f32x4 cs[4];
                if (kind != 0) { const f32x4* rp = (const f32x4*)(rope + (size_t)row * 16);
#pragma unroll
                    for (int i = 0; i < 4; ++i) cs[i] = rp[i]; }
#pragma unroll
                for (int bj = 0; bj < 2; ++bj) {
                    f32x4 v0 = acc[ai][bj][m][0], v1 = acc[ai][bj][m][1];
                    if (kind == 0) {
#pragma unroll
                        for (int e = 0; e < 4; ++e) { v0[e] = gelu_tanh(v0[e]); v1[e] = gelu_tanh(v1[e]); }
                    } else {
                        if (kind == 1 || bj == 0) {
                            f32x4 p0, p1;
#pragma unroll
                            for (int e = 0; e < 4; ++e) { p0[e] = __shfl_xor(v0[e], 16); p1[e] = __shfl_xor(v1[e], 16); }
                            if (ropelane) {
#pragma unroll
                                for (int e = 0; e < 4; ++e) {
                                    const float c0 = cs[e >> 1][(e & 1) * 2], s0 = cs[e >> 1][(e & 1) * 2 + 1];
                                    const float c1 = cs[2 + (e >> 1)][(e & 1) * 2], s1 = cs[2 + (e >> 1)][(e & 1) * 2 + 1];
                                    v0[e] = v0[e] * c0 + sgn * p0[e] * s0;
                                    v1[e] = v1[e] * c1 + sgn * p1[e] * s1;
                                }
                            }
                        }
                        if (kind == 1) { v0 = v0 * qscale; v1 = v1 * qscale; }
                    }
                    u32x4 w; w.x = cvt_pk_bf16(v0[0], v0[1]); w.y = cvt_pk_bf16(v0[2], v0[3]); w.z = cvt_pk_bf16(v1[0], v1[1]); w.w = cvt_pk_bf16(v1[2], v1[3]);
                    *(u32x4*)(rowp + bj * HALF) = w;
                }
            }
    }
};
struct EpiRelu2 {
    static constexpr bool PERM = true, AFTER_DRAIN = false;
    bf16_t* O; int ldc;
    __device__ __forceinline__ void operator()(const f32x4 (&acc)[2][2][4][2], const Unit& u, int wr, int wc, int fr, int fq) const {
        const int row0 = u.pm * BM + wr * 64 + fr, col0 = u.pn * BM + wc * 32 + 8 * fq;
#pragma unroll
        for (int ai = 0; ai < 2; ++ai)
#pragma unroll
            for (int m = 0; m < 4; ++m) { bf16_t* rowp = O + (size_t)(row0 + ai * HALF + m * 16) * ldc + col0;
#pragma unroll
                for (int bj = 0; bj < 2; ++bj) { f32x4 v0 = acc[ai][bj][m][0], v1 = acc[ai][bj][m][1];
#pragma unroll
                    for (int e = 0; e < 4; ++e) { const float a = fmaxf(v0[e], 0.f), b = fmaxf(v1[e], 0.f); v0[e] = a * a; v1[e] = b * b; }
                    u32x4 w; w.x = cvt_pk_bf16(v0[0], v0[1]); w.y = cvt_pk_bf16(v0[2], v0[3]); w.z = cvt_pk_bf16(v1[0], v1[1]); w.w = cvt_pk_bf16(v1[2], v1[3]);
                    *(u32x4*)(rowp + bj * HALF) = w; } }
    }
};
struct EpiResid {
    static constexpr bool PERM = false, AFTER_DRAIN = false;
    const float* base; float* out; const float* gate; int gate_ld;
    __device__ __forceinline__ void operator()(const f32x4 (&acc)[2][2][4][2], const Unit& u, int wr, int wc, int fr, int fq) const {
        constexpr int ldc = 1024;
        const int b = u.pm >> 4;
        const int col0 = u.pn * BM + wc * 32 + 4 * fq;
        f32x4 gv[2][2];
#pragma unroll
        for (int bj = 0; bj < 2; ++bj)
#pragma unroll
            for (int n = 0; n < 2; ++n) gv[bj][n] = *(const f32x4*)(gate + (size_t)b * gate_ld + col0 + bj * HALF + n * 16);
#pragma unroll
        for (int ai = 0; ai < 2; ++ai)
#pragma unroll
            for (int m = 0; m < 4; ++m) { const size_t off = (size_t)(u.pm * BM + ai * HALF + wr * 64 + m * 16 + fr) * ldc + col0;
#pragma unroll
                for (int bj = 0; bj < 2; ++bj)
#pragma unroll
                    for (int n = 0; n < 2; ++n) { const f32x4 bs = *(const f32x4*)(base + off + bj * HALF + n * 16);
                        *(f32x4*)(out + off + bj * HALF + n * 16) = bs + gv[bj][n] * acc[ai][bj][m][n]; }
                if (m & 1) asm volatile("" ::: "memory"); }
    }
};

template <class Epi, class Sched, bool ALIGN_EPI = false, bool SP2 = false>
__device__ __forceinline__ void gemm_phase(PG8_LAS unsigned char* lds, const Gemm g, const Sched& S, const Epi& E) {
    const int tid = threadIdx.x, wid = __builtin_amdgcn_readfirstlane(tid >> 6), lane = tid & 63, wr = wid >> 2, wc = wid & 3, fr = lane & 15, fq = lane >> 4;
    const int K = g.K, nt = K / BK;
    unsigned voffA[2], voffB[2];
#pragma unroll
    for (int i = 0; i < 2; ++i) { int R, C; stage_rc(tid * 16 + i * 8192, R, C); const int Rb = Epi::PERM ? ((R & ~31) + perm32(R & 31)) : R;
        voffA[i] = (unsigned)(R * K + C) * 2u; voffB[i] = (unsigned)(Rb * K + C) * 2u; }
    const size_t kstep = (size_t)(BK * 2);
    const size_t hstep = (size_t)HALF * K * 2;
    const size_t tstep = 2 * hstep;
    const unsigned ldsw = (unsigned)wid * 1024u;
    const int aoff = lds_byte(wr * 64 + fr, fq * 8), boff = lds_byte(wc * 32 + fr, fq * 8);
#define PG8_SA(b, h) (((b) * 2 + (h)) * HTB)
#define PG8_SB(b, h) ((4 + (b) * 2 + (h)) * HTB)
#define PG8_STAGE(bufoff, gbase, voff) do { _Pragma("unroll") for (int _i = 0; _i < 2; ++_i) \
        __builtin_amdgcn_global_load_lds((const unsigned*)((const char*)(gbase) + (voff)[_i]), (PG8_LAS unsigned*)(lds + (bufoff) + ldsw + _i * 8192), 16, 0, 0); } while (0)
#define PG8_LDA(dst, b, h) do { _Pragma("unroll") for (int m = 0; m < 4; ++m) _Pragma("unroll") for (int k = 0; k < 2; ++k) dst[m][k] = *(const PG8_LAS bf16x8*)(lds + PG8_SA(b, h) + aoff + m * 2048 + k * 1024); } while (0)
#define PG8_LDB(dst, b, h) do { _Pragma("unroll") for (int n = 0; n < 2; ++n) _Pragma("unroll") for (int k = 0; k < 2; ++k) dst[n][k] = *(const PG8_LAS bf16x8*)(lds + PG8_SB(b, h) + boff + n * 2048 + k * 1024); } while (0)
#define PG8_MMA(ai, bj, At, Bt) do { __builtin_amdgcn_s_setprio(1); _Pragma("unroll") for (int m = 0; m < 4; ++m) _Pragma("unroll") for (int n = 0; n < 2; ++n) _Pragma("unroll") for (int k = 0; k < 2; ++k) \
        acc[ai][bj][m][n] = __builtin_amdgcn_mfma_f32_16x16x32_bf16(Bt[n][k], At[m][k], acc[ai][bj][m][n], 0, 0, 0); __builtin_amdgcn_s_setprio(0); } while (0)
#define PG8_WAIT_V(n) asm volatile("s_waitcnt vmcnt(" #n ")" ::: "memory")
#define PG8_WAIT_L(n) asm volatile("s_waitcnt lgkmcnt(" #n ")" ::: "memory")
#define PG8_BAR __builtin_amdgcn_s_barrier()
#define PG8_SCHED __builtin_amdgcn_sched_barrier(0)
    Unit cur, nxt; int ui = 0;
    if (!S.next(0, cur)) return;
    f32x4 acc[2][2][4][2];
#pragma unroll
    for (int a = 0; a < 2; ++a)
#pragma unroll
        for (int b = 0; b < 2; ++b)
#pragma unroll
            for (int m = 0; m < 4; ++m)
#pragma unroll
                for (int n = 0; n < 2; ++n) acc[a][b][m][n] = (f32x4){0.f, 0.f, 0.f, 0.f};
    bf16x8 At[4][2], B0[2][2], B1[2][2];
    const char* cA = (const char*)g.A + (size_t)cur.pm * tstep; const char* cB = (const char*)g.Bt + (size_t)cur.pn * tstep;
    S.a_ready(cur);
    if constexpr (SP2) {
        PG8_STAGE(PG8_SB(0, 0), cB, voffB); PG8_STAGE(PG8_SB(0, 1), cB + hstep, voffB); PG8_STAGE(PG8_SA(0, 0), cA, voffA); PG8_STAGE(PG8_SA(0, 1), cA + hstep, voffA);
        if (wr == 1) PG8_BAR;
        PG8_WAIT_V(2); PG8_BAR;
        PG8_STAGE(PG8_SB(1, 0), cB + kstep, voffB); PG8_STAGE(PG8_SA(1, 0), cA + kstep, voffA); PG8_STAGE(PG8_SB(1, 1), cB + hstep + kstep, voffB);
        PG8_WAIT_V(6); PG8_BAR;
    } else {
        PG8_STAGE(PG8_SB(0, 0), cB, voffB); PG8_STAGE(PG8_SA(0, 0), cA, voffA); PG8_STAGE(PG8_SB(0, 1), cB + hstep, voffB); PG8_STAGE(PG8_SA(0, 1), cA + hstep, voffA);
        if (wr == 1) PG8_BAR;
        PG8_WAIT_V(4); PG8_BAR;
        PG8_STAGE(PG8_SB(1, 0), cB + kstep, voffB); PG8_STAGE(PG8_SA(1, 0), cA + kstep, voffA); PG8_STAGE(PG8_SB(1, 1), cB + hstep + kstep, voffB);
        PG8_WAIT_V(6); PG8_BAR;
    }
    for (;;) {
        const bool has_next = S.next(ui + 1, nxt);
        const char* nA = has_next ? (const char*)g.A + (size_t)nxt.pm * tstep : cA; const char* nB = has_next ? (const char*)g.Bt + (size_t)nxt.pn * tstep : cB;
        for (int t = 0; t < nt; t += 2) {
            const bool last = (t == nt - 2);
            const char* a1 = cA + (size_t)(t + 1) * kstep;
            const char* a2 = last ? nA : cA + (size_t)(t + 2) * kstep; const char* b2 = last ? nB : cB + (size_t)(t + 2) * kstep;
            const char* a3 = a2 + kstep; const char* b3 = b2 + kstep;
            if (last && has_next) S.a_ready(nxt);
            if constexpr (SP2) {
            PG8_LDB(B0, 0, 0); PG8_LDB(B1, 0, 1); PG8_SCHED; PG8_LDA(At, 0, 0); PG8_STAGE(PG8_SA(1, 1), a1 + hstep, voffA);
            PG8_WAIT_V(8); PG8_WAIT_L(0); PG8_BAR; PG8_MMA(0, 0, At, B0); PG8_MMA(0, 1, At, B1); PG8_BAR; PG8_SCHED;
            PG8_LDA(At, 0, 1); PG8_STAGE(PG8_SB(0, 0), b2, voffB); PG8_STAGE(PG8_SB(0, 1), b2 + hstep, voffB); PG8_STAGE(PG8_SA(0, 0), a2, voffA);
            PG8_WAIT_V(8); PG8_WAIT_L(0); PG8_BAR; PG8_MMA(1, 0, At, B0); PG8_MMA(1, 1, At, B1); PG8_BAR; PG8_SCHED;
            PG8_LDB(B0, 1, 0); PG8_LDB(B1, 1, 1); PG8_SCHED; PG8_LDA(At, 1, 0); PG8_STAGE(PG8_SA(0, 1), a2 + hstep, voffA);
            PG8_WAIT_V(8); PG8_WAIT_L(0); PG8_BAR; PG8_MMA(0, 0, At, B0); PG8_MMA(0, 1, At, B1); PG8_BAR; PG8_SCHED;
            PG8_LDA(At, 1, 1); PG8_STAGE(PG8_SB(1, 0), b3, voffB); PG8_STAGE(PG8_SB(1, 1), b3 + hstep, voffB); PG8_STAGE(PG8_SA(1, 0), a3, voffA);
            PG8_WAIT_V(8); PG8_WAIT_L(0); PG8_BAR; PG8_MMA(1, 0, At, B0); PG8_MMA(1, 1, At, B1); PG8_BAR; PG8_SCHED;
            } else {
            PG8_LDB(B0, 0, 0); PG8_SCHED; PG8_LDA(At, 0, 0); PG8_STAGE(PG8_SA(1, 1), a1 + hstep, voffA);
            PG8_WAIT_L(8); PG8_BAR; PG8_WAIT_L(0); PG8_MMA(0, 0, At, B0); PG8_BAR; PG8_SCHED;
            PG8_LDB(B1, 0, 1); PG8_STAGE(PG8_SB(0, 0), b2, voffB);
            PG8_BAR; PG8_WAIT_L(0); PG8_MMA(0, 1, At, B1); PG8_BAR;
            PG8_LDA(At, 0, 1); PG8_STAGE(PG8_SA(0, 0), a2, voffA);
            PG8_BAR; PG8_WAIT_L(0); PG8_MMA(1, 0, At, B0); PG8_BAR; PG8_SCHED;
            PG8_STAGE(PG8_SB(0, 1), b2 + hstep, voffB);
            PG8_WAIT_V(6); PG8_BAR; PG8_MMA(1, 1, At, B1); PG8_BAR;
            PG8_LDB(B0, 1, 0); PG8_SCHED; PG8_LDA(At, 1, 0); PG8_STAGE(PG8_SA(0, 1), a2 + hstep, voffA);
            PG8_WAIT_L(8); PG8_BAR; PG8_WAIT_L(0); PG8_MMA(0, 0, At, B0); PG8_BAR; PG8_SCHED;
            PG8_LDB(B1, 1, 1); PG8_STAGE(PG8_SB(1, 0), b3, voffB);
            PG8_BAR; PG8_WAIT_L(0); PG8_MMA(0, 1, At, B1); PG8_BAR;
            PG8_LDA(At, 1, 1); PG8_STAGE(PG8_SA(1, 0), a3, voffA);
            PG8_BAR; PG8_WAIT_L(0); PG8_MMA(1, 0, At, B0); PG8_BAR; PG8_SCHED;
            PG8_STAGE(PG8_SB(1, 1), b3 + hstep, voffB);
            PG8_WAIT_V(6); PG8_BAR; PG8_MMA(1, 1, At, B1); PG8_BAR;
            }
        }
        if constexpr (ALIGN_EPI) { if (wr == 0) PG8_BAR; }
        if constexpr (!Epi::AFTER_DRAIN) { E(acc, cur, wr, wc, fr, fq); S.done(cur); }
        if (!has_next) break;
#pragma unroll
        for (int a = 0; a < 2; ++a)
#pragma unroll
            for (int b = 0; b < 2; ++b)
#pragma unroll
                for (int m = 0; m < 4; ++m)
#pragma unroll
                    for (int n = 0; n < 2; ++n) acc[a][b][m][n] = (f32x4){0.f, 0.f, 0.f, 0.f};
        cur = nxt; cA = nA; cB = nB; ++ui;
        if constexpr (ALIGN_EPI) { if (wr == 1) PG8_BAR; }
    }
    PG8_WAIT_V(0);
    if constexpr (!ALIGN_EPI) { if (wr == 0) PG8_BAR; }
    PG8_BAR;
    if constexpr (Epi::AFTER_DRAIN) { E.fused(acc, cur, wr, wc, fr, fq, lds, wid, lane); S.done(cur); }
#undef PG8_SA
#undef PG8_SB
#undef PG8_STAGE
#undef PG8_LDA
#undef PG8_LDB
#undef PG8_MMA
#undef PG8_WAIT_V
#undef PG8_WAIT_L
#undef PG8_BAR
#undef PG8_SCHED
}
}

constexpr int NB = 8, SEQ = 4096, D = 1024, M = NB * SEQ, NPROJ = 1792, FF = 4096, NMOD = 6144, KSPLIT = 32;
constexpr float RMS_EPS = 1e-5f;
constexpr float LOG2E = 1.4426950408889634f;
constexpr float QSCALE = 0.125f * LOG2E;
constexpr int NWAVES = 8, NTHREADS = NWAVES * 64;
constexpr int N_PHASES = 9;
#ifndef MK_MULTI
#define MK_MULTI 0
#endif

constexpr size_t MiB = 1u << 20;
constexpr size_t WS_CTL = 0, CTL_ZERO_BYTES = 65536;
constexpr size_t WS_WIN = 2 * MiB, WS_WOUT = 6 * MiB, WS_W1 = 8 * MiB, WS_W2 = 16 * MiB;
constexpr size_t WS_MOD = 24 * MiB;
constexpr size_t WS_ROPE = 25 * MiB;
constexpr size_t WS_WSP = 27 * MiB;
constexpr size_t WS_MODP = 28 * MiB;
constexpr size_t WS_XN = 40 * MiB;
constexpr size_t WS_PROJ = 104 * MiB;
constexpr size_t WS_MIX = 216 * MiB;
constexpr size_t WS_HID = 104 * MiB;
constexpr size_t WS_END = 360 * MiB;

constexpr int RING_BYTES = 131072;
constexpr int LDS_BYTES = 147456;

#define LAS __attribute__((address_space(3)))
typedef unsigned short bf16;
typedef unsigned v4u __attribute__((ext_vector_type(4)));
typedef unsigned v2u __attribute__((ext_vector_type(2)));
typedef float f32x4 __attribute__((ext_vector_type(4)));
typedef float f32x16 __attribute__((ext_vector_type(16)));
typedef short bf16x8 __attribute__((ext_vector_type(8)));
typedef short s16x4 __attribute__((ext_vector_type(4)));
#define LDS_WAIT() asm volatile("s_waitcnt lgkmcnt(0)" ::: "memory")

__device__ __forceinline__ unsigned f2bf(float f) { unsigned u = __builtin_bit_cast(unsigned, f); return (u + 0x7fffu + ((u >> 16) & 1u)) >> 16; }
__device__ __forceinline__ unsigned pk2(float lo, float hi) { return f2bf(lo) | (f2bf(hi) << 16); }
__device__ __forceinline__ float bflo(unsigned u) { return __builtin_bit_cast(float, u << 16); }
__device__ __forceinline__ float bfhi(unsigned u) { return __builtin_bit_cast(float, u & 0xffff0000u); }
__device__ __forceinline__ float wave_sum(float v) {
#pragma unroll
    for (int o = 1; o < 64; o <<= 1) v += __shfl_xor(v, o);
    return v;
}

struct Args {
    const float *x, *c; const int* pos; const float *w_ada, *b_ada, *g_mix, *w_in, *w_sp, *b_sp, *sinks, *w_out, *g_ffn, *w_ff1, *w_ff2, *g_final;
    float* out; unsigned char* ws; int ph_lo, ph_hi;
};

__device__ __forceinline__ void p0_transpose_item(const float* W, int K, int N, bf16* WT, LAS float* scr, int item, int lane) {
    const int nblk = N / 32, kb = item / nblk, nb = item % nblk, k0 = 64 * kb, n0 = 32 * nb;
#pragma unroll 8
    for (int i = 0; i < 32; ++i) { const int kk = 2 * i + (lane >> 5); scr[kk * 33 + (lane & 31)] = W[(size_t)(k0 + kk) * N + n0 + (lane & 31)]; }
    LDS_WAIT(); asm volatile("" ::: "memory");
    const int c = lane & 7;
#pragma unroll
    for (int j = 0; j < 4; ++j) { const int n = (lane >> 3) + 8 * j; const LAS float* s = scr + (8 * c) * 33 + n;
        v4u o; o.x = pk2(s[0 * 33], s[1 * 33]); o.y = pk2(s[2 * 33], s[3 * 33]); o.z = pk2(s[4 * 33], s[5 * 33]); o.w = pk2(s[6 * 33], s[7 * 33]);
        *(v4u*)(WT + (size_t)(n0 + n) * K + k0 + 8 * c) = o; }
    LDS_WAIT(); asm volatile("" ::: "memory");
}
__device__ __forceinline__ void p0_mod_item(const float* c, const float* w_ada, float* modp, LAS float* scr, int item, int lane) {
    const int cb = item % 24, ks = item / 24;
#pragma unroll
    for (int i = 0; i < 4; ++i) { const int idx = lane * 4 + i, b = idx >> 5, kk = idx & 31; const float v = c[b * D + ks * 32 + kk]; scr[idx] = v / (1.0f + __expf(-v)); }
    LDS_WAIT(); asm volatile("" ::: "memory");
    f32x4 acc[8];
#pragma unroll
    for (int b = 0; b < 8; ++b) acc[b] = (f32x4){0.f, 0.f, 0.f, 0.f};
    const f32x4* wp = (const f32x4*)(w_ada + (size_t)(ks * 32) * NMOD + cb * 256) + lane;
#pragma unroll 8
    for (int kk = 0; kk < 32; ++kk) { const f32x4 w = wp[(size_t)kk * (NMOD / 4)];
#pragma unroll
        for (int b = 0; b < 8; ++b) acc[b] += scr[b * 32 + kk] * w; }
#pragma unroll
    for (int b = 0; b < 8; ++b) *(f32x4*)(modp + (size_t)(ks * 8 + b) * NMOD + cb * 256 + lane * 4) = acc[b];
    LDS_WAIT(); asm volatile("" ::: "memory");
}
__device__ __forceinline__ void p0_rope_item(const int* pos, float* rope, int item, int lane) {
    const int idx = item * 64 + lane, m = idx >> 3, i = idx & 7;
    const float invf = i == 0 ? 1.0f : i == 1 ? 0.19392274474868576f : i == 2 ? 0.03760603093086393f : i == 3 ? 0.007292664737217109f
                     : i == 4 ? 0.001414213562373095f : i == 5 ? 0.0002742481756762073f : i == 6 ? 5.318295896944988e-05f : 1.031338537721246e-05f;
    const float ang = (float)pos[m] * invf;
    const double a = (double)ang, k = __builtin_rint(a * 0.15915494309189535), r = a - k * 6.283185307179586;
    const float rf = (float)r;
    float2 cs; cs.x = cosf(rf); cs.y = sinf(rf);
    *(float2*)(rope + (size_t)idx * 2) = cs;
}
__device__ __forceinline__ void p0_wsp_item(const float* w_sp, bf16* wsp, int item, int lane) {
    const int e0 = (item * 64 + lane) * 4, t = (e0 >> 7) & 127, s0 = e0 & 127;
    f32x4 v = *(const f32x4*)(w_sp + e0);
#pragma unroll
    for (int j = 0; j < 4; ++j) if (s0 + j > t) v[j] = 0.f;
    v2u o; o.x = pk2(v[0], v[1]); o.y = pk2(v[2], v[3]);
    *(v2u*)(wsp + e0) = o;
}

template <bool FIRST>
__device__ __forceinline__ void norm_mod_pass(LAS unsigned char* lds, const float* xin, const float* g, const float* b_ada, const float* modp, float* mod, int shift_off, int scale_off, bf16* out) {
    const int tid = threadIdx.x, lane = tid & 63, wave = tid >> 6;
    LAS float* GS = (LAS float*)lds; LAS float* SH = GS + D;
    for (int grp = blockIdx.x; grp < 256; grp += gridDim.x) {
        const int b = grp >> 5, j = grp & 31;
        if (FIRST) {
            for (int col = tid; col < 2 * D; col += NTHREADS) {
                float s = b_ada[col];
                for (int ks = 0; ks < KSPLIT; ++ks) s += modp[(size_t)(ks * 8 + b) * NMOD + col];
                if (col < D) SH[col] = s; else GS[col - D] = g[col - D] * (1.0f + s);
            }
            if (tid < 128) { const int col = 2 * D + j * 128 + tid;
                float s = b_ada[col];
                for (int ks = 0; ks < KSPLIT; ++ks) s += modp[(size_t)(ks * 8 + b) * NMOD + col];
                mod[(size_t)b * NMOD + col] = s; }
        } else {
            for (int col = tid; col < D; col += NTHREADS) { SH[col] = mod[(size_t)b * NMOD + shift_off + col]; GS[col] = g[col] * (1.0f + mod[(size_t)b * NMOD + scale_off + col]); }
        }
        __syncthreads();
        for (int i = 0; i < 16; ++i) {
            const size_t row = (size_t)b * SEQ + j * 128 + wave * 16 + i;
            const f32x4* xr = (const f32x4*)(xin + row * D) + lane;
            f32x4 v[4]; float s = 0.f;
#pragma unroll
            for (int q = 0; q < 4; ++q) { v[q] = xr[64 * q]; s += (v[q].x * v[q].x + v[q].y * v[q].y) + (v[q].z * v[q].z + v[q].w * v[q].w); }
            const float rstd = 1.0f / sqrtf(wave_sum(s) * (1.0f / D) + RMS_EPS);
            unsigned long long* o8 = (unsigned long long*)(out + row * D) + lane;
#pragma unroll
            for (int q = 0; q < 4; ++q) { const f32x4 gs = *(const LAS f32x4*)(GS + 256 * q + 4 * lane), sh = *(const LAS f32x4*)(SH + 256 * q + 4 * lane);
                const f32x4 y = v[q] * rstd * gs + sh;
                o8[64 * q] = (unsigned long long)pk2(y.x, y.y) | ((unsigned long long)pk2(y.z, y.w) << 32); }
        }
        __syncthreads();
    }
}
__device__ __forceinline__ void final_norm_pass(float* io, const float* g) {
    const int lane = threadIdx.x & 63, gw = blockIdx.x * NWAVES + (threadIdx.x >> 6), NGW = gridDim.x * NWAVES;
    f32x4 gv[4];
#pragma unroll
    for (int q = 0; q < 4; ++q) gv[q] = *((const f32x4*)g + lane + 64 * q);
    for (int m = gw; m < M; m += NGW) {
        f32x4* xr = (f32x4*)(io + (size_t)m * D) + lane;
        f32x4 v[4]; float s = 0.f;
#pragma unroll
        for (int q = 0; q < 4; ++q) { v[q] = xr[64 * q]; s += (v[q].x * v[q].x + v[q].y * v[q].y) + (v[q].z * v[q].z + v[q].w * v[q].w); }
        const float rstd = 1.0f / sqrtf(wave_sum(s) * (1.0f / D) + RMS_EPS);
#pragma unroll
        for (int q = 0; q < 4; ++q) xr[64 * q] = v[q] * rstd * gv[q];
    }
}

__device__ __forceinline__ int crow(int r, int hi) { return (r & 3) + 8 * (r >> 2) + 4 * hi; }
__device__ __forceinline__ s16x4 vtr(LAS const unsigned char* p) { return __builtin_bit_cast(s16x4, __builtin_amdgcn_ds_read_tr16_b64_v4i16((LAS s16x4*)p)); }
__device__ __forceinline__ bf16x8 vfrag(LAS const unsigned char* vb, int key0) {
    const s16x4 lo = vtr(vb + key0 * 64), hi = vtr(vb + key0 * 64 + 512);
    return (bf16x8){lo[0], lo[1], lo[2], lo[3], hi[0], hi[1], hi[2], hi[3]};
}
__device__ __forceinline__ unsigned cvtpk(float lo, float hi) { return pg8::cvt_pk_bf16(lo, hi); }

__device__ __forceinline__ void sgu_unit(LAS unsigned char* lds, const bf16* proj, const bf16* wsp, const float* b_sp, bf16* mix, int b, int c) {
    const int tid = threadIdx.x, lane = tid & 63, h = tid >> 6, hi = lane >> 5;
    const size_t m0 = (size_t)b * SEQ + c * 128;
    LAS unsigned char* vl = lds + h * 16384;
#pragma unroll
    for (int half = 0; half < 2; ++half) {
        v4u tmp[8];
#pragma unroll
        for (int i = 0; i < 8; ++i) { const int idx = lane + 64 * (half * 8 + i), row = idx >> 3, ch = idx & 7;
            tmp[i] = *(const v4u*)(proj + (m0 + row) * NPROJ + 512 + h * 64 + ch * 8); }
#pragma unroll
        for (int i = 0; i < 8; ++i) { const int idx = lane + 64 * (half * 8 + i), row = idx >> 3, ch = idx & 7;
            *(LAS v4u*)(vl + (ch >> 2) * 8192 + row * 64 + (ch & 3) * 16) = tmp[i]; }
    }
    LDS_WAIT(); asm volatile("" ::: "memory");
    const int lofs = (4 * hi + ((lane & 15) >> 2)) * 64 + 32 * ((lane >> 4) & 1) + 8 * (lane & 3);
    LAS const unsigned char* vb0 = vl + lofs; LAS const unsigned char* vb1 = vl + 8192 + lofs;
#pragma unroll
    for (int tt = 0; tt < 4; ++tt) {
        f32x16 acc0 = {}, acc1 = {};
        const int t = 32 * tt + (lane & 31);
        const bf16* wrow = wsp + ((size_t)h * 128 + t) * 128;
#pragma unroll
        for (int j = 0; j < 2 * (tt + 1); ++j) {
            const v2u w0 = *(const v2u*)(wrow + 16 * j + 4 * hi), w1 = *(const v2u*)(wrow + 16 * j + 8 + 4 * hi);
            const bf16x8 bw = __builtin_bit_cast(bf16x8, ((v4u){w0.x, w0.y, w1.x, w1.y}));
            const bf16x8 a0 = vfrag(vb0, 16 * j), a1 = vfrag(vb1, 16 * j);
            acc0 = __builtin_amdgcn_mfma_f32_32x32x16_bf16(a0, bw, acc0, 0, 0, 0);
            acc1 = __builtin_amdgcn_mfma_f32_32x32x16_bf16(a1, bw, acc1, 0, 0, 0);
        }
        const float bias = b_sp[h * 128 + t];
        const size_t mrow = m0 + t;
#pragma unroll
        for (int dblk = 0; dblk < 2; ++dblk)
#pragma unroll
            for (int rg = 0; rg < 4; ++rg) {
                const int d = 32 * dblk + 8 * rg + 4 * hi;
                const v2u uu = *(const v2u*)(proj + mrow * NPROJ + h * 64 + d);
                const f32x16& a = dblk ? acc1 : acc0;
                const float o0 = (a[4 * rg + 0] + bias) * bflo(uu.x), o1 = (a[4 * rg + 1] + bias) * bfhi(uu.x);
                const float o2 = (a[4 * rg + 2] + bias) * bflo(uu.y), o3 = (a[4 * rg + 3] + bias) * bfhi(uu.y);
                v2u o; o.x = cvtpk(o0, o1); o.y = cvtpk(o2, o3);
                *(v2u*)(mix + mrow * D + h * 64 + d) = o;
            }
    }
}

constexpr int AT_KSTRIDE = 144, AT_VOFF = 256 * AT_KSTRIDE;
__device__ __forceinline__ void attn_unit(LAS unsigned char* lds, const bf16* proj, const float* sinks, bf16* mix, int b, int n, int hk) {
    const int tid = threadIdx.x, lane = tid & 63, wave = tid >> 6, hi = lane >> 5, qi = lane & 31;
    const long m0 = (long)b * SEQ + n * 128;
    LAS unsigned char* kl = lds; LAS unsigned char* vl = lds + AT_VOFF;
#pragma unroll
    for (int i = 0; i < 4; ++i) {
        const int idx = tid + NTHREADS * i, row = idx >> 3, ch = idx & 7;
        const bool valid = (n > 0) || (row >= 128);
        v4u kk = (v4u){0u, 0u, 0u, 0u}, vv = (v4u){0u, 0u, 0u, 0u};
        if (valid) { const bf16* src = proj + (size_t)(m0 - 128 + row) * NPROJ + hk * 64 + ch * 8; kk = *(const v4u*)(src + 1536); vv = *(const v4u*)(src + 1664); }
        *(LAS v4u*)(kl + row * AT_KSTRIDE + ch * 16) = kk;
        *(LAS v4u*)(vl + (ch >> 2) * 16384 + row * 64 + (ch & 3) * 16) = vv;
    }
    __syncthreads();
    const int hq = hk * 4 + (wave >> 1);
    const float sink2 = sinks[hq] * LOG2E;
    const int lofs = (4 * hi + ((lane & 15) >> 2)) * 64 + 32 * ((lane >> 4) & 1) + 8 * (lane & 3);
    LAS const unsigned char* vb0 = vl + lofs; LAS const unsigned char* vb1 = vl + 16384 + lofs;
    const float NEG = -__builtin_inff();
#pragma unroll 1
    for (int sub = 0; sub < 2; ++sub) {
        const int i0 = 64 * (wave & 1) + 32 * sub, jt0 = i0 >> 5;
        const size_t mrow = (size_t)(m0 + i0 + qi);
        bf16x8 qf[4];
#pragma unroll
        for (int ds = 0; ds < 4; ++ds) qf[ds] = *(const bf16x8*)(proj + mrow * NPROJ + 1024 + hq * 64 + 16 * ds + 8 * hi);
        f32x16 S[5];
#pragma unroll
        for (int tt = 0; tt < 5; ++tt) {
            LAS const unsigned char* kp = kl + (32 * (jt0 + tt) + qi) * AT_KSTRIDE + 16 * hi;
            f32x16 s = {};
#pragma unroll
            for (int ds = 0; ds < 4; ++ds) { const bf16x8 kf = *(LAS const bf16x8*)(kp + 32 * ds); s = __builtin_amdgcn_mfma_f32_32x32x16_bf16(kf, qf[ds], s, 0, 0, 0); }
            S[tt] = s;
        }
#pragma unroll
        for (int r = 0; r < 16; ++r) { const int kr = crow(r, hi); if (!(kr > qi)) S[0][r] = NEG; if (!(kr <= qi)) S[4][r] = NEG; }
        if (n == 0) {
#pragma unroll
            for (int tt = 0; tt < 5; ++tt) if (jt0 + tt < 4) {
#pragma unroll
                for (int r = 0; r < 16; ++r) S[tt][r] = NEG; }
        }
        float mx = sink2;
#pragma unroll
        for (int tt = 0; tt < 5; ++tt)
#pragma unroll
            for (int r = 0; r < 16; ++r) mx = fmaxf(mx, S[tt][r]);
        mx = fmaxf(mx, __shfl_xor(mx, 32));
        float sum = 0.f;
#pragma unroll
        for (int tt = 0; tt < 5; ++tt)
#pragma unroll
            for (int r = 0; r < 16; ++r) { const float p = __builtin_amdgcn_exp2f(S[tt][r] - mx); S[tt][r] = p; sum += p; }
        sum += __shfl_xor(sum, 32);
        sum += __builtin_amdgcn_exp2f(sink2 - mx);
        const float inv = 1.0f / sum;
        f32x16 O0 = {}, O1 = {};
#pragma unroll
        for (int tt = 0; tt < 5; ++tt)
#pragma unroll
            for (int ks = 0; ks < 2; ++ks) {
                const v4u pw = (v4u){cvtpk(S[tt][8 * ks + 0], S[tt][8 * ks + 1]), cvtpk(S[tt][8 * ks + 2], S[tt][8 * ks + 3]), cvtpk(S[tt][8 * ks + 4], S[tt][8 * ks + 5]), cvtpk(S[tt][8 * ks + 6], S[tt][8 * ks + 7])};
                const bf16x8 pb = __builtin_bit_cast(bf16x8, pw);
                const int key0 = 32 * (jt0 + tt) + 16 * ks;
                const bf16x8 a0 = vfrag(vb0, key0), a1 = vfrag(vb1, key0);
                O0 = __builtin_amdgcn_mfma_f32_32x32x16_bf16(a0, pb, O0, 0, 0, 0);
                O1 = __builtin_amdgcn_mfma_f32_32x32x16_bf16(a1, pb, O1, 0, 0, 0);
            }
#pragma unroll
        for (int dblk = 0; dblk < 2; ++dblk)
#pragma unroll
            for (int rg = 0; rg < 4; ++rg) {
                const int d = 32 * dblk + 8 * rg + 4 * hi;
                const f32x16& a = dblk ? O1 : O0;
                v2u o; o.x = cvtpk(a[4 * rg + 0] * inv, a[4 * rg + 1] * inv); o.y = cvtpk(a[4 * rg + 2] * inv, a[4 * rg + 3] * inv);
                *(v2u*)(mix + mrow * D + 512 + hq * 64 + d) = o;
            }
    }
    __syncthreads();
}

#define XB_TMO      128
#define XB_XCNT(j)  (256  + 64 * (j))
#define XB_XSUB(j)  (1280 + 64 * (j))
#define XB_XGEN(j)  (2304 + 64 * (j))
#define XB_TOP      3328
#define XB_TOPGEN   3392
#define XCD_BAR_WORDS 3456
#define XB_SPIN_CAP (1u << 18)

__device__ __forceinline__ unsigned xb_ld(unsigned* p)              { return __hip_atomic_load(p, __ATOMIC_RELAXED, __HIP_MEMORY_SCOPE_AGENT); }
__device__ __forceinline__ unsigned xb_add(unsigned* p, unsigned v) { return __hip_atomic_fetch_add(p, v, __ATOMIC_RELAXED, __HIP_MEMORY_SCOPE_AGENT); }
__device__ __forceinline__ unsigned xb_xcc_id() { return (unsigned)__builtin_amdgcn_s_getreg((3 << 11) | 20) & 0xFu; }
#define XB_SPIN(cond, bar) do { unsigned _sp = 0; while (cond) { __builtin_amdgcn_s_sleep(1); \
    if ((++_sp & 255u) == 0u) { if (xb_ld(&(bar)[XB_TMO])) break; if (_sp > XB_SPIN_CAP) { atomicAdd(&(bar)[XB_TMO], 1u); break; } } } } while (0)

struct XcdBarrier {
    unsigned* bar; unsigned x;
    volatile LAS unsigned* st;
};

__device__ __forceinline__ XcdBarrier xcd_barrier_post(unsigned* bar, volatile LAS unsigned* st) {
    XcdBarrier b; b.bar = bar; b.x = xb_xcc_id(); b.st = st;
    if (threadIdx.x == 0) (void)xb_add(&bar[XB_XCNT(b.x)], 1u);
    return b;
}
__device__ __forceinline__ void xcd_barrier_complete(unsigned* bar, unsigned x, unsigned& nloc, unsigned& nx) {
    const unsigned G = gridDim.x * gridDim.y * gridDim.z;
    unsigned sum, cnt, mine, sp = 0u;
    for (;;) {
        sum = 0u; cnt = 0u; mine = 0u;
#pragma unroll
        for (unsigned j = 0; j < 16; ++j) { const unsigned c = xb_ld(&bar[XB_XCNT(j)]); sum += c; cnt += (c > 0u) ? 1u : 0u; mine = (j == x) ? c : mine; }
        if (sum == G) break;
        __builtin_amdgcn_s_sleep(1);
        if ((++sp & 255u) == 0u) { if (xb_ld(&bar[XB_TMO])) break; if (sp > XB_SPIN_CAP) { atomicAdd(&bar[XB_TMO], 1u); break; } }
    }
    nloc = mine > 0u ? mine : 1u; nx = cnt > 0u ? cnt : 1u;
}

__device__ __forceinline__ void xcd_barrier(const XcdBarrier& b) {
    asm volatile("s_waitcnt vmcnt(0)" ::: "memory");
    __syncthreads();
    if (threadIdx.x == 0) {
        unsigned* bar = b.bar;
        __builtin_amdgcn_s_waitcnt(0);
        unsigned nloc = b.st[0], nx = b.st[1];
        if (nloc == 0u) { xcd_barrier_complete(bar, b.x, nloc, nx); b.st[0] = nloc; b.st[1] = nx; }
        const unsigned old = xb_add(&bar[XB_XSUB(b.x)], 1u);
        const unsigned gen = old / nloc;
        if (old + 1u == (gen + 1u) * nloc) {
            __builtin_amdgcn_fence(__ATOMIC_RELEASE, "agent");
            asm volatile("s_waitcnt vmcnt(0)" ::: "memory");
            const unsigned og = xb_add(&bar[XB_TOP], 1u);
            const unsigned tg = og / nx;
            if (og + 1u == (tg + 1u) * nx) xb_add(&bar[XB_TOPGEN], 1u);
            else XB_SPIN(xb_ld(&bar[XB_TOPGEN]) == tg, bar);
            __builtin_amdgcn_fence(__ATOMIC_ACQUIRE, "agent");
            xb_add(&bar[XB_XGEN(b.x)], 1u);
            asm volatile("s_waitcnt vmcnt(0)" ::: "memory");
        } else {
            XB_SPIN(xb_ld(&bar[XB_XGEN(b.x)]) == gen, bar);
            __builtin_amdgcn_fence(__ATOMIC_ACQUIRE, "agent");
            asm volatile("s_waitcnt vmcnt(0)" ::: "memory");
        }
    }
    __syncthreads();
}

__global__ void __launch_bounds__(NTHREADS, 2) mk_fwd(Args args) {
    extern __shared__ __attribute__((aligned(16))) unsigned char lds_raw[];
    LAS unsigned char* lds = (LAS unsigned char*)lds_raw;
    const int tid = threadIdx.x, lane = tid & 63, wave = __builtin_amdgcn_readfirstlane(tid >> 6);
    const int G = gridDim.x;
    unsigned char* ws = args.ws;
    bf16* Win_t = (bf16*)(ws + WS_WIN); bf16* Wout_t = (bf16*)(ws + WS_WOUT); bf16* W1_t = (bf16*)(ws + WS_W1); bf16* W2_t = (bf16*)(ws + WS_W2);
    float* MOD = (float*)(ws + WS_MOD); float* ROPE = (float*)(ws + WS_ROPE); bf16* WSP = (bf16*)(ws + WS_WSP); float* MODP = (float*)(ws + WS_MODP);
    bf16* XN = (bf16*)(ws + WS_XN); bf16* PROJ = (bf16*)(ws + WS_PROJ); bf16* MIX = (bf16*)(ws + WS_MIX); bf16* HID = (bf16*)(ws + WS_HID);
    const int lo = args.ph_lo, hi = args.ph_hi;
    volatile LAS unsigned* bst = (volatile LAS unsigned*)(lds + RING_BYTES);
    if (tid < 2) bst[tid] = 0u;
    __syncthreads();
    XcdBarrier bar; bar.bar = (unsigned*)(ws + WS_CTL); bar.x = 0; bar.st = bst;
    if (!MK_MULTI) bar = xcd_barrier_post((unsigned*)(ws + WS_CTL), bst);
    if (hi > 1000) cg::this_grid().sync();
#define IN(k) (lo <= (k) && (k) < hi)
#define SEAM(k) do { if (IN(k) && IN((k) + 1)) { xcd_barrier(bar); } } while (0)

    if (IN(0)) {
        LAS float* scr = (LAS float*)(lds + wave * 16384);
        const int gw = blockIdx.x * NWAVES + wave, NGW = G * NWAVES;
        constexpr int I_MOD = 24 * KSPLIT, I_IN = (D / 64) * (NPROJ / 32), I_OUT = (D / 64) * (D / 32), I_1 = (D / 64) * (FF / 32), I_2 = (FF / 64) * (D / 32);
        constexpr int I_ROPE = M * 8 / 64, I_WSP = 8 * 128 * 128 / 256;
        constexpr int NITEMS = I_MOD + I_IN + I_OUT + I_1 + I_2 + I_ROPE + I_WSP;
        for (int it = gw; it < NITEMS; it += NGW) {
            int r = it;
            if (r < I_MOD) { p0_mod_item(args.c, args.w_ada, MODP, scr, r, lane); continue; } r -= I_MOD;
            if (r < I_IN) { p0_transpose_item(args.w_in, D, NPROJ, Win_t, scr, r, lane); continue; } r -= I_IN;
            if (r < I_OUT) { p0_transpose_item(args.w_out, D, D, Wout_t, scr, r, lane); continue; } r -= I_OUT;
            if (r < I_1) { p0_transpose_item(args.w_ff1, D, FF, W1_t, scr, r, lane); continue; } r -= I_1;
            if (r < I_2) { p0_transpose_item(args.w_ff2, FF, D, W2_t, scr, r, lane); continue; } r -= I_2;
            if (r < I_ROPE) { p0_rope_item(args.pos, ROPE, r, lane); continue; } r -= I_ROPE;
            p0_wsp_item(args.w_sp, WSP, r, lane);
        }
    }
    SEAM(0);
    if (IN(1)) norm_mod_pass<true>(lds, args.x, args.g_mix, args.b_ada, MODP, MOD, 0, 0, XN);
    SEAM(1);
    if (IN(2)) {
        pg8::Gemm g{XN, Win_t, M, NPROJ, D}; pg8::StaticOrder S; S.init(M, NPROJ, G, (int)blockIdx.x);
        pg8::EpiIn E{PROJ, ROPE, QSCALE};
        pg8::gemm_phase<pg8::EpiIn, pg8::StaticOrder, true, true>(lds, g, S, E);
    }
    SEAM(2);
    if (IN(3)) {
        for (int u = blockIdx.x; u < 768; u += G) {
            if (u < 256) { sgu_unit(lds, PROJ, WSP, args.b_sp, MIX, u >> 5, u & 31); __syncthreads(); }
            else { const int idx = u - 256; attn_unit(lds, PROJ, args.sinks, MIX, idx >> 6, (idx >> 1) & 31, idx & 1); }
        }
    }
    SEAM(3);
    if (IN(4)) {
        pg8::Gemm g{MIX, Wout_t, M, D, D}; pg8::StaticOrder S; S.init(M, D, G, (int)blockIdx.x);
        pg8::EpiResid E{args.x, args.out, MOD + 2 * D, NMOD};
        pg8::gemm_phase<pg8::EpiResid, pg8::StaticOrder, true, true>(lds, g, S, E);
    }
    SEAM(4);
    if (IN(5)) norm_mod_pass<false>(lds, args.out, args.g_ffn, args.b_ada, MODP, MOD, 3 * D, 4 * D, XN);
    SEAM(5);
    if (IN(6)) {
        pg8::Gemm g{XN, W1_t, M, FF, D}; pg8::StaticOrder S; S.init(M, FF, G, (int)blockIdx.x);
        pg8::EpiRelu2 E{HID, FF};
        pg8::gemm_phase<pg8::EpiRelu2, pg8::StaticOrder, true, true>(lds, g, S, E);
    }
    SEAM(6);
    if (IN(7)) {
        pg8::Gemm g{HID, W2_t, M, D, FF}; pg8::StaticOrder S; S.init(M, D, G, (int)blockIdx.x);
        pg8::EpiResid E{args.out, args.out, MOD + 5 * D, NMOD};
        pg8::gemm_phase<pg8::EpiResid, pg8::StaticOrder, true, true>(lds, g, S, E);
    }
    SEAM(7);
    if (IN(8)) final_norm_pass(args.out, args.g_final);
#undef IN
#undef SEAM
}

extern "C" void kernel_launch(void* const* d_in, const int* in_sizes, int n_in, void* d_out, int out_size, void* d_ws, size_t ws_size, hipStream_t stream) {
    static int grid = 0;
    if (grid == 0) {
        if (n_in != 15 || in_sizes[0] != M * D || out_size != M * D || ws_size < WS_END) { fprintf(stderr, "kernel_launch: unexpected shapes (n_in %d, in0 %d, out %d, ws %zu); nothing launched\n", n_in, n_in > 0 ? in_sizes[0] : -1, out_size, ws_size); grid = -1; return; }
        int dev = 0, cus = 0, per_cu = 0;
        if (hipGetDevice(&dev) != hipSuccess || hipDeviceGetAttribute(&cus, hipDeviceAttributeMultiprocessorCount, dev) != hipSuccess) { grid = -1; return; }
        if (hipFuncSetAttribute((const void*)mk_fwd, hipFuncAttributeMaxDynamicSharedMemorySize, LDS_BYTES) != hipSuccess) { fprintf(stderr, "kernel_launch: hipFuncSetAttribute failed\n"); grid = -1; return; }
        if (hipOccupancyMaxActiveBlocksPerMultiprocessor(&per_cu, (const void*)mk_fwd, NTHREADS, LDS_BYTES) != hipSuccess || per_cu < 1) { fprintf(stderr, "kernel_launch: occupancy query says %d\n", per_cu); per_cu = 1; }
        (void)hipGetLastError();
        grid = cus * per_cu;
        if (grid > 256) grid = 256;
    }
    if (grid < 0) return;
    Args a{};
    a.x = (const float*)d_in[0]; a.c = (const float*)d_in[1]; a.pos = (const int*)d_in[2]; a.w_ada = (const float*)d_in[3]; a.b_ada = (const float*)d_in[4];
    a.g_mix = (const float*)d_in[5]; a.w_in = (const float*)d_in[6]; a.w_sp = (const float*)d_in[7]; a.b_sp = (const float*)d_in[8]; a.sinks = (const float*)d_in[9];
    a.w_out = (const float*)d_in[10]; a.g_ffn = (const float*)d_in[11]; a.w_ff1 = (const float*)d_in[12]; a.w_ff2 = (const float*)d_in[13]; a.g_final = (const float*)d_in[14];
    a.out = (float*)d_out; a.ws = (unsigned char*)d_ws;
#if MK_MULTI
    for (int ph = 0; ph < N_PHASES; ++ph) { a.ph_lo = ph; a.ph_hi = ph + 1; hipLaunchKernelGGL(mk_fwd, dim3(grid), dim3(NTHREADS), LDS_BYTES, stream, a); }
#else
    a.ph_lo = 0; a.ph_hi = N_PHASES;
    if (hipMemsetAsync((char*)d_ws + WS_CTL, 0, CTL_ZERO_BYTES, stream) != hipSuccess) { fprintf(stderr, "kernel_launch: memset of the control words failed\n"); return; }
    void* kargs[] = {&a};
    hipError_t e = hipLaunchCooperativeKernel((const void*)mk_fwd, dim3(grid), dim3(NTHREADS), kargs, LDS_BYTES, stream);
    if (e != hipSuccess) fprintf(stderr, "kernel_launch: cooperative launch failed: %s (grid %d)\n", hipGetErrorString(e), grid);
#endif
}
```
